# Optimizing an MI355X kernel written in HIP

```python
import math
import jax, jax.numpy as jnp
from jax import lax
import numpy as np

D_MODEL = 2048
BATCH = 16
SEQ = 2048
DEPTH = 2

A_HEADS = 8
A_HEAD_DIM = 64
A_Q_RANK = 384
A_KV_RANK = 256
IDX_HEADS = 16
IDX_DIM = 64
DSA_TOPK = 256
DSA_Q_BLOCK = 128
SSM_GROUP = 16
SSM_GROUPS = 32
SSM_WIDTH = SSM_GROUP * SSM_GROUPS
SSM_STATE = 64
C_HEADS = 8
C_HEAD_DIM = 64
MOBA_BLOCK = 256
MOBA_TOPK = 3
MOBA_Q_BLOCK = 32
N_BRANCH = 3
BRANCH_WIDTH = 512
D_FF = 256 * math.ceil(8 * D_MODEL / 3 / 256)
CONV_WIDTH = 3
REL_BUCKETS = 32
REL_MAX_DIST = 128
LN_EPS = 1e-5
NEG_INF = -1e30
DEEPNORM_ALPHA = (2 * DEPTH) ** 0.25
DEEPNORM_BETA = (8 * DEPTH) ** -0.25
IN_SPLITS = (A_Q_RANK, A_KV_RANK, IDX_DIM, IDX_HEADS, SSM_WIDTH,
             C_HEADS * C_HEAD_DIM, C_HEADS * C_HEAD_DIM, C_HEADS * C_HEAD_DIM,
             N_BRANCH * D_MODEL)
IN_WIDTH = sum(IN_SPLITS)

kernel_name = 'dsa_s5_moba_gated_hybrid'

F32 = jnp.float32


def _split_points(sizes):
    pts, acc = [], 0
    for s in sizes[:-1]:
        acc += s
        pts.append(acc)
    return pts


def layer_norm(x, g, b):
    xf = x.astype(F32)
    mu = xf.mean(-1, keepdims=True)
    var = jnp.square(xf - mu).mean(-1, keepdims=True)
    return ((xf - mu) * lax.rsqrt(var + LN_EPS) * g.astype(F32) + b.astype(F32)).astype(x.dtype)


def rms_norm(x, g):
    xf = x.astype(F32)
    return (xf * lax.rsqrt(jnp.mean(xf * xf, -1, keepdims=True) + LN_EPS) * g.astype(F32)).astype(x.dtype)


def t5_bucket(dist):
    n = jnp.maximum(dist, 0)
    exact = REL_BUCKETS // 2
    log_ratio = jnp.log(jnp.maximum(n, 1).astype(F32) / exact) / math.log(REL_MAX_DIST / exact)
    large = jnp.minimum(exact + (log_ratio * (REL_BUCKETS - exact)).astype(jnp.int32), REL_BUCKETS - 1)
    return jnp.where(n < exact, n, large)


def to_chunks(a, q):
    return jnp.moveaxis(a.reshape(a.shape[0], a.shape[1] // q, q, *a.shape[2:]), 1, 0)


def from_chunks(a):
    a = jnp.moveaxis(a, 0, 1)
    return a.reshape(a.shape[0], a.shape[1] * a.shape[2], *a.shape[3:])


def dsa_mixer(c_q, c_kv, k_idx, w_idx, w_uq, w_uk, w_uv, w_qidx, bias_tab):
    Bn, T, _ = c_q.shape
    n_top = min(DSA_TOPK, T // 4)
    q = jnp.einsum('btr,rhd->bthd', c_q, w_uq)
    q_lat = jnp.einsum('bthd,chd->bthc', q, w_uk) * A_HEAD_DIM ** -0.5
    q_idx = jnp.einsum('btr,rhd->bthd', c_q, w_qidx) * IDX_DIM ** -0.5
    w_idx = w_idx * IDX_HEADS ** -0.5
    key_pos = jnp.arange(T)

    def attend(args):
        ql, qi, wi, qpos = args
        rel = jax.nn.relu(jnp.einsum('bqhd,bsd->bqhs', qi, k_idx))
        score = jnp.einsum('bqh,bqhs->bqs', wi, rel).astype(F32)
        score = jnp.where(qpos[:, None] >= key_pos[None, :], score, -jnp.inf)
        _, idx = lax.top_k(score, n_top)
        kv = jax.vmap(lambda c, i: c[i])(c_kv, idx)
        dist = qpos[None, :, None] - idx
        logits = (jnp.einsum('bqhc,bqkc->bqhk', ql, kv).astype(F32)
                  + jnp.moveaxis(bias_tab[t5_bucket(dist)].astype(F32), -1, 2))
        logits = jnp.where((dist >= 0)[:, :, None, :], logits, NEG_INF)
        p = jax.nn.softmax(logits, axis=-1).astype(c_kv.dtype)
        return jnp.einsum('bqhk,bqkc->bqhc', p, kv)

    pos = jnp.arange(T).reshape(T // DSA_Q_BLOCK, DSA_Q_BLOCK)
    o_lat = from_chunks(lax.map(attend, (to_chunks(q_lat, DSA_Q_BLOCK), to_chunks(q_idx, DSA_Q_BLOCK),
                                         to_chunks(w_idx, DSA_Q_BLOCK), pos)))
    o = jnp.einsum('bthc,chd->bthd', o_lat, w_uv)
    return o.reshape(Bn, T, A_HEADS * A_HEAD_DIM)


def s5_mixer(u, lam_re, lam_im, log_step, b_re, b_im, c_re, c_im, d_skip, w_glu, b_glu):
    Bn, T, _ = u.shape
    uf = u.astype(F32).reshape(Bn, T, SSM_GROUPS, SSM_GROUP)
    lam = lax.complex(lam_re.astype(F32), lam_im.astype(F32))
    step = jnp.exp(log_step.astype(F32))[:, None]
    lam_bar = jnp.exp(lam * step)
    b_bar = ((lam_bar - 1.0) / lam)[:, :, None] * lax.complex(b_re.astype(F32), b_im.astype(F32))
    bu = jnp.einsum('btgp,gnp->btgn', uf.astype(jnp.complex64), b_bar)
    a = jnp.broadcast_to(lam_bar, (1, T) + lam_bar.shape)

    def combine(l, r):
        return l[0] * r[0], r[0] * l[1] + r[1]

    _, state = lax.associative_scan(combine, (a, bu), axis=1)
    c = lax.complex(c_re.astype(F32), c_im.astype(F32))
    y = jnp.real(jnp.einsum('btgn,gpn->btgp', state, c)) + d_skip.astype(F32).reshape(SSM_GROUPS, SSM_GROUP) * uf
    y = jax.nn.gelu(y.reshape(Bn, T, SSM_WIDTH)).astype(u.dtype)
    return y * jax.nn.sigmoid(y @ w_glu + b_glu)


def moba_mixer(q, k, v, bias_tab):
    Bn, T, H, Dh = q.shape
    n_blk = -(-T // MOBA_BLOCK)
    pad = ((0, 0), (0, n_blk * MOBA_BLOCK - T), (0, 0), (0, 0))
    k_p, v_p = jnp.pad(k, pad), jnp.pad(v, pad)
    k_mean = k_p.astype(F32).reshape(Bn, n_blk, MOBA_BLOCK, H, Dh).mean(2)
    own = jnp.arange(T) // MOBA_BLOCK
    gate = jnp.einsum('bthd,bnhd->bthn', q.astype(F32), k_mean)
    past = jnp.arange(n_blk)[None, :] < own[:, None]
    gate = jnp.where(past[None, :, None, :], gate, -jnp.inf)
    n_sel = min(MOBA_TOPK, n_blk)
    _, sel = lax.top_k(gate, n_sel)
    k_bh = jnp.transpose(k_p.reshape(Bn, n_blk, MOBA_BLOCK, H, Dh), (0, 3, 1, 2, 4))
    v_bh = jnp.transpose(v_p.reshape(Bn, n_blk, MOBA_BLOCK, H, Dh), (0, 3, 1, 2, 4))
    scale = Dh ** -0.5
    tab_t = bias_tab.astype(F32).T
    head_ix = jnp.arange(H)[None, :, None, None, None]
    gather = jax.vmap(jax.vmap(lambda blocks, s: blocks[s]))

    def attend(args):
        qc, selc, start = args
        qpos = start + jnp.arange(MOBA_Q_BLOCK)
        own_blk = start // MOBA_BLOCK
        ob = own_blk * MOBA_BLOCK
        k_own = lax.dynamic_slice_in_dim(k_p, ob, MOBA_BLOCK, axis=1)
        v_own = lax.dynamic_slice_in_dim(v_p, ob, MOBA_BLOCK, axis=1)
        d_own = qpos[:, None] - (ob + jnp.arange(MOBA_BLOCK))[None, :]
        l_own = jnp.einsum('bqhd,bshd->bhqs', qc, k_own).astype(F32) * scale + tab_t[:, t5_bucket(d_own)]
        l_own = jnp.where(d_own >= 0, l_own, NEG_INF)
        sel_bh = jnp.transpose(selc, (0, 2, 1, 3))
        k_sel = gather(k_bh, sel_bh)
        v_sel = gather(v_bh, sel_bh)
        d_sel = qpos[:, None, None] - (sel_bh[..., None] * MOBA_BLOCK + jnp.arange(MOBA_BLOCK))
        l_sel = (jnp.einsum('bqhd,bhqjsd->bhqjs', qc, k_sel).astype(F32) * scale
                 + tab_t[head_ix, t5_bucket(d_sel)])
        l_sel = jnp.where((sel_bh < own_blk)[..., None], l_sel, NEG_INF)
        logits = jnp.concatenate([l_own, l_sel.reshape(Bn, H, MOBA_Q_BLOCK, n_sel * MOBA_BLOCK)], axis=-1)
        p = jax.nn.softmax(logits, axis=-1).astype(v.dtype)
        p_own = p[..., :MOBA_BLOCK]
        p_sel = p[..., MOBA_BLOCK:].reshape(Bn, H, MOBA_Q_BLOCK, n_sel, MOBA_BLOCK)
        return (jnp.einsum('bhqs,bshd->bqhd', p_own, v_own)
                + jnp.einsum('bhqjs,bhqjsd->bqhd', p_sel, v_sel))

    starts = jnp.arange(T // MOBA_Q_BLOCK) * MOBA_Q_BLOCK
    o = from_chunks(lax.map(attend, (to_chunks(q, MOBA_Q_BLOCK), to_chunks(sel, MOBA_Q_BLOCK), starts)))
    return o.reshape(Bn, T, H * Dh)


def mixer_block(x, rel_bias, w_in, cq_gain, ckv_gain, w_uq, w_uk, w_uv, w_qidx,
                lam_re, lam_im, log_step, b_re, b_im, c_re, c_im, d_skip, w_glu, b_glu,
                w_branch, w_out):
    Bn, T, _ = x.shape
    h = jnp.einsum('btd,dn->btn', x, w_in)
    c_q, c_kv, k_idx, w_idx, u, q_c, k_c, v_c, g = jnp.split(h, _split_points(IN_SPLITS), axis=-1)
    o_a = dsa_mixer(rms_norm(c_q, cq_gain), rms_norm(c_kv, ckv_gain), k_idx, w_idx,
                    w_uq, w_uk, w_uv, w_qidx, rel_bias[:, :A_HEADS])
    o_b = s5_mixer(u, lam_re, lam_im, log_step, b_re, b_im, c_re, c_im, d_skip, w_glu, b_glu)
    head_shape = (Bn, T, C_HEADS, C_HEAD_DIM)
    o_c = moba_mixer(q_c.reshape(head_shape), k_c.reshape(head_shape), v_c.reshape(head_shape),
                     rel_bias[:, A_HEADS:])
    o = jnp.stack([o_a, o_b, o_c], axis=2)
    y = jnp.einsum('btnc,ncd->btnd', o, w_branch)
    gate = jax.nn.sigmoid(g.reshape(Bn, T, N_BRANCH, D_MODEL))
    merged = jnp.einsum('btnd,btnd->btd', gate, y)
    return merged @ w_out


def conv_ffn(x, w_up, conv_w, conv_b, w_down):
    T = x.shape[1]
    h = x @ w_up
    hp = jnp.pad(h, ((0, 0), (CONV_WIDTH - 1, 0), (0, 0)))
    h = conv_b + sum(hp[:, j:j + T] * conv_w[j] for j in range(CONV_WIDTH))
    a, val = jnp.split(h, 2, axis=-1)
    return (jax.nn.gelu(a) * val) @ w_down


def setup_inputs(seed: int = 0) -> dict:
    key = jax.random.key(seed)
    ks = iter(jax.random.split(key, 40))

    def nrm(shape, scale):
        return jax.random.normal(next(ks), shape, F32) * scale

    L = DEPTH
    beta = DEEPNORM_BETA
    x = nrm((BATCH, SEQ, D_MODEL), 1.0)
    rel_bias = nrm((REL_BUCKETS, A_HEADS + C_HEADS), 0.2)
    w_in = nrm((L, D_MODEL, IN_WIDTH), D_MODEL ** -0.5)
    cq_gain = 1.0 + nrm((L, A_Q_RANK), 0.01)
    ckv_gain = 1.0 + nrm((L, A_KV_RANK), 0.01)
    w_uq = nrm((L, A_Q_RANK, A_HEADS, A_HEAD_DIM), A_Q_RANK ** -0.5)
    w_uk = nrm((L, A_KV_RANK, A_HEADS, A_HEAD_DIM), A_KV_RANK ** -0.5)
    w_uv = nrm((L, A_KV_RANK, A_HEADS, A_HEAD_DIM), beta * A_KV_RANK ** -0.5)
    w_qidx = nrm((L, A_Q_RANK, IDX_HEADS, IDX_DIM), A_Q_RANK ** -0.5)
    lam_re = -0.5 + nrm((L, SSM_GROUPS, SSM_STATE), 0.01)
    lam_im = math.pi * jnp.arange(SSM_STATE, dtype=F32) + nrm((L, SSM_GROUPS, SSM_STATE), 0.01)
    log_step = jax.random.uniform(next(ks), (L, SSM_GROUPS), F32, math.log(1e-3), math.log(1e-1))
    b_re = nrm((L, SSM_GROUPS, SSM_STATE, SSM_GROUP), (2 * SSM_GROUP) ** -0.5)
    b_im = nrm((L, SSM_GROUPS, SSM_STATE, SSM_GROUP), (2 * SSM_GROUP) ** -0.5)
    c_re = nrm((L, SSM_GROUPS, SSM_GROUP, SSM_STATE), 0.5)
    c_im = nrm((L, SSM_GROUPS, SSM_GROUP, SSM_STATE), 0.5)
    d_skip = nrm((L, SSM_WIDTH), 1.0)
    w_glu = nrm((L, SSM_WIDTH, SSM_WIDTH), SSM_WIDTH ** -0.5)
    b_glu = nrm((L, SSM_WIDTH), 0.01)
    w_branch = nrm((L, N_BRANCH, BRANCH_WIDTH, D_MODEL), beta * BRANCH_WIDTH ** -0.5)
    w_out = nrm((L, D_MODEL, D_MODEL), beta * D_MODEL ** -0.5)
    ln1_g = 1.0 + nrm((L, D_MODEL), 0.01)
    ln1_b = nrm((L, D_MODEL), 0.01)
    w_up = nrm((L, D_MODEL, 2 * D_FF), beta * D_MODEL ** -0.5)
    conv_w = nrm((L, CONV_WIDTH, 2 * D_FF), CONV_WIDTH ** -0.5)
    conv_b = nrm((L, 2 * D_FF), 0.01)
    w_down = nrm((L, D_FF, D_MODEL), beta * D_FF ** -0.5)
    ln2_g = 1.0 + nrm((L, D_MODEL), 0.01)
    ln2_b = nrm((L, D_MODEL), 0.01)
    return {'x': x, 'rel_bias': rel_bias, 'w_in': w_in, 'cq_gain': cq_gain, 'ckv_gain': ckv_gain,
            'w_uq': w_uq, 'w_uk': w_uk, 'w_uv': w_uv, 'w_qidx': w_qidx,
            'lam_re': lam_re, 'lam_im': lam_im, 'log_step': log_step, 'b_re': b_re, 'b_im': b_im,
            'c_re': c_re, 'c_im': c_im, 'd_skip': d_skip, 'w_glu': w_glu, 'b_glu': b_glu,
            'w_branch': w_branch, 'w_out': w_out, 'ln1_g': ln1_g, 'ln1_b': ln1_b,
            'w_up': w_up, 'conv_w': conv_w, 'conv_b': conv_b, 'w_down': w_down,
            'ln2_g': ln2_g, 'ln2_b': ln2_b}


def reference(x, rel_bias, w_in, cq_gain, ckv_gain, w_uq, w_uk, w_uv, w_qidx,
              lam_re, lam_im, log_step, b_re, b_im, c_re, c_im, d_skip, w_glu, b_glu,
              w_branch, w_out, ln1_g, ln1_b, w_up, conv_w, conv_b, w_down, ln2_g, ln2_b):
    for l in range(DEPTH):
        mix = mixer_block(x, rel_bias, w_in[l], cq_gain[l], ckv_gain[l], w_uq[l], w_uk[l], w_uv[l], w_qidx[l],
                          lam_re[l], lam_im[l], log_step[l], b_re[l], b_im[l], c_re[l], c_im[l],
                          d_skip[l], w_glu[l], b_glu[l], w_branch[l], w_out[l])
        x = layer_norm(DEEPNORM_ALPHA * x + mix, ln1_g[l], ln1_b[l])
        x = layer_norm(DEEPNORM_ALPHA * x + conv_ffn(x, w_up[l], conv_w[l], conv_b[l], w_down[l]),
                       ln2_g[l], ln2_b[l])
    return x
```

```cpp
#include <hip/hip_runtime.h>
#include <hip/hip_cooperative_groups.h>
#include <cstdio>
#include <cstdint>
namespace cg = cooperative_groups;

typedef unsigned short u16;
typedef __attribute__((ext_vector_type(8))) short bf16x8;
typedef __attribute__((ext_vector_type(4))) float f32x4;
typedef __attribute__((ext_vector_type(4))) unsigned int u32x4;
typedef __attribute__((ext_vector_type(2))) unsigned int u32x2;

constexpr int T = 2048, NB = 16, NTOK = NB * T, DM = 2048;
constexpr int INW = 8912, NA = 2768, NAP = 2816;
constexpr int DFF = 5632;
constexpr float ALPHA = 1.41421356237f;
constexpr int SMEM_BYTES = 131072 + 256;
constexpr int NTH = 512;

constexpr size_t MiB = 1048576;
constexpr size_t O_WINHI = 0, O_WINLO = 11 * MiB, O_WG = 22 * MiB, O_WQHI = 46 * MiB, O_WQLO = 47 * MiB + 512 * 1024,
                 O_WUK = 49 * MiB, O_WUVP = 49 * MiB + 512 * 1024, O_WGLU = 50 * MiB, O_WBR = 51 * MiB, O_WOUT = 57 * MiB,
                 O_WUP = 65 * MiB, O_WDOWN = 109 * MiB, O_KTAB = 131 * MiB, O_CM = 132 * MiB, O_BM = 136 * MiB,
                 O_LAML = 140 * MiB, O_BIASD = 140 * MiB + 512 * 1024;
constexpr size_t O_X1 = 144 * MiB;
constexpr size_t O_XL = 144 * MiB, O_XH = 272 * MiB;
constexpr size_t O_QIHI = 144 * MiB, O_QILO = 208 * MiB, O_SCR = 972 * MiB, O_SLOC = 1004 * MiB, O_SPREV = 400 * MiB;
constexpr size_t O_MRG = 144 * MiB, O_GATE = 208 * MiB, O_X1B = 752 * MiB;
constexpr size_t O_CQ = 400 * MiB, O_CKV = 448 * MiB, O_KIDX = 480 * MiB, O_WIDX = 488 * MiB, O_U = 490 * MiB, O_QC = 522 * MiB,
                 O_KC = 586 * MiB, O_KCB = 650 * MiB, O_VT = 682 * MiB, O_CQNHI = 714 * MiB, O_CQNLO = 738 * MiB,
                 O_CKVN = 762 * MiB, O_CKVNT = 778 * MiB, O_KIHI = 794 * MiB, O_KILO = 798 * MiB, O_KMEAN = 802 * MiB,
                 O_MSEL = 803 * MiB, O_Q = 804 * MiB, O_MASK = 836 * MiB, O_YACT = 844 * MiB, O_OA = 876 * MiB, O_OB = 908 * MiB,
                 O_OC = 940 * MiB;
constexpr size_t O_MERGED = 400 * MiB, O_ACT = 400 * MiB;
constexpr size_t O_WUVBD = 141 * MiB, O_OLAT = 144 * MiB;

#define NOSPLIT 1
struct PK {
  const float* in[29];
  float* out;
  char* ws;
};
#define LAS __attribute__((address_space(3)))
struct P {
  const LAS unsigned long long* tab;
  float* out;
  char* ws;
  __device__ __forceinline__ const float* in(int i) const {
    unsigned addr = (unsigned)(size_t)tab;
    asm volatile("" : "+s"(addr));
    const unsigned long long v = *(const LAS unsigned long long*)(size_t)(addr + 8u * (unsigned)i);
    const unsigned lo = __builtin_amdgcn_readfirstlane((unsigned)v), hi = __builtin_amdgcn_readfirstlane((unsigned)(v >> 32));
    return (const float*)(__attribute__((address_space(1))) const float*)(((unsigned long long)hi << 32) | (unsigned long long)lo);
  }
};

__device__ __forceinline__ u16 f2bf(float f) {
  uint32_t u = __float_as_uint(f);
  u += 0x7fffu + ((u >> 16) & 1u);
  return (u16)(u >> 16);
}
__device__ __forceinline__ float bf2f(u16 h) { return __uint_as_float(((uint32_t)h) << 16); }
__device__ __forceinline__ uint32_t pack2(float a, float b) { return (uint32_t)f2bf(a) | ((uint32_t)f2bf(b) << 16); }
__device__ __forceinline__ float sigmoidf_(float x) { return 1.f / (1.f + __expf(-x)); }
__device__ __forceinline__ float gelu_tanh(float x) {
  float u = 0.7978845608028654f * (x + 0.044715f * x * x * x);
  return x * sigmoidf_(2.f * u);
}
__device__ __forceinline__ float wave_sum(float v) {
#pragma unroll
  for (int o = 32; o >= 1; o >>= 1) v += __shfl_xor(v, o);
  return v;
}
__device__ __forceinline__ f32x4 mfma16(bf16x8 a, bf16x8 b, f32x4 c) {
  return __builtin_amdgcn_mfma_f32_16x16x32_bf16(a, b, c, 0, 0, 0);
}
__device__ __forceinline__ int opaque(int x) {
  asm volatile("" : "+v"(x));
  return x;
}
__device__ __forceinline__ int opaque_s(int x) {
  asm volatile("" : "+s"(x));
  return x;
}
template <class Tp>
__device__ __forceinline__ Tp* opaque_p(Tp* q) {
  __attribute__((address_space(1))) Tp* g = (__attribute__((address_space(1))) Tp*)q;
  asm volatile("" : "+s"(g));
  return (Tp*)g;
}
union U4 {
  uint4 v;
  bf16x8 h;
  uint32_t w[4];
  u16 s[8];
};

constexpr int G_BK = 64, G_HALF = 128, G_HT = G_HALF * G_BK;
__device__ __forceinline__ int lds_byte(int r, int c) {
  int st = (r >> 4) * 2 + (c >> 5), rr = r & 15, cc = c & 31, ob = rr * 64 + cc * 2;
  return st * 1024 + (ob ^ (((ob >> 9) & 1) << 5));
}
__device__ __forceinline__ void stage_rc(int b, int& R, int& C) {
  int st = b / 1024, sb = b % 1024, swz = sb ^ (((sb >> 9) & 1) << 5);
  R = (st >> 1) * 16 + swz / 64;
  C = (st & 1) * 32 + (swz % 64) / 2;
}
typedef f32x4 Acc256[2][2][4][2];
__device__ __forceinline__ void zero256(Acc256& acc) {
#pragma unroll
  for (int a = 0; a < 2; ++a)
#pragma unroll
    for (int b = 0; b < 2; ++b)
#pragma unroll
      for (int m = 0; m < 4; ++m)
#pragma unroll
        for (int n = 0; n < 2; ++n) acc[a][b][m][n] = f32x4{0.f, 0.f, 0.f, 0.f};
}
__device__ __forceinline__ void gemm256(Acc256& acc, const u16* A, int lda, const u16* Bt, int ldb, int K, char* shmc) {
  LAS unsigned char* lds = (LAS unsigned char*)shmc;
  constexpr int HTB = G_HT * 2;
  const int tid = opaque(threadIdx.x), wid = __builtin_amdgcn_readfirstlane(tid >> 6), lane = tid & 63, wr = wid >> 2, wc = wid & 3, fr = lane & 15, fq = lane >> 4;
  const int nt = K / G_BK;
  unsigned voffA[2], voffB[2];
#pragma unroll
  for (int i = 0; i < 2; ++i) {
    int R, C;
    stage_rc(tid * 16 + i * 8192, R, C);
    voffA[i] = (unsigned)(R * lda + C) * 2u;
    voffB[i] = (unsigned)(R * ldb + C) * 2u;
  }
  const size_t kstep = (size_t)(G_BK * 2);
  const size_t hA = (size_t)G_HALF * lda * 2, hB = (size_t)G_HALF * ldb * 2;
  const unsigned ldsw = (unsigned)wid * 1024u;
  const int aoff = lds_byte(wr * 64 + fr, fq * 8), boff = lds_byte(wc * 32 + fr, fq * 8);
  const char* cA = (const char*)A;
  const char* cB = (const char*)Bt;
#define G_SA(b, h) (((b) * 2 + (h)) * HTB)
#define G_SB(b, h) ((4 + (b) * 2 + (h)) * HTB)
#define G_STAGE(bufoff, gbase, voff)                                                                                   \
  do {                                                                                                                 \
    _Pragma("unroll") for (int _i = 0; _i < 2; ++_i)                                                                   \
        __builtin_amdgcn_global_load_lds((const unsigned*)((const char*)(gbase) + (voff)[_i]),                         \
                                         (LAS unsigned*)(lds + (bufoff) + ldsw + _i * 8192), 16, 0, 0);                \
  } while (0)
#define G_LDA(dst, b, h)                                                                                               \
  do {                                                                                                                 \
    _Pragma("unroll") for (int m = 0; m < 4; ++m) _Pragma("unroll") for (int k = 0; k < 2; ++k)                        \
        dst[m][k] = *(const LAS bf16x8*)(lds + G_SA(b, h) + aoff + m * 2048 + k * 1024);                               \
  } while (0)
#define G_LDB(dst, b, h)                                                                                               \
  do {                                                                                                                 \
    _Pragma("unroll") for (int n = 0; n < 2; ++n) _Pragma("unroll") for (int k = 0; k < 2; ++k)                        \
        dst[n][k] = *(const LAS bf16x8*)(lds + G_SB(b, h) + boff + n * 2048 + k * 1024);                               \
  } while (0)
#define G_MMA(ai, bj, At_, Bt_)                                                                                        \
  do {                                                                                                                 \
    __builtin_amdgcn_s_setprio(1);                                                                                     \
    _Pragma("unroll") for (int m = 0; m < 4; ++m) _Pragma("unroll") for (int n = 0; n < 2; ++n)                        \
        _Pragma("unroll") for (int k = 0; k < 2; ++k) acc[ai][bj][m][n] =                                              \
            __builtin_amdgcn_mfma_f32_16x16x32_bf16(At_[m][k], Bt_[n][k], acc[ai][bj][m][n], 0, 0, 0);                 \
    __builtin_amdgcn_s_setprio(0);                                                                                     \
  } while (0)
#define WAIT_V(n) asm volatile("s_waitcnt vmcnt(" #n ")" ::: "memory")
#define WAIT_L(n) asm volatile("s_waitcnt lgkmcnt(" #n ")" ::: "memory")
#define BAR __builtin_amdgcn_s_barrier()
#define SCHED __builtin_amdgcn_sched_barrier(0)
  bf16x8 At[4][2], B0[2][2], B1[2][2];
  asm volatile("s_waitcnt vmcnt(0) lgkmcnt(0)" ::: "memory");
  __syncthreads();
  G_STAGE(G_SB(0, 0), cB, voffB); G_STAGE(G_SA(0, 0), cA, voffA); G_STAGE(G_SB(0, 1), cB + hB, voffB); G_STAGE(G_SA(0, 1), cA + hA, voffA);
  if (wr == 1) BAR;
  WAIT_V(4); BAR;
  G_STAGE(G_SB(1, 0), cB + kstep, voffB); G_STAGE(G_SA(1, 0), cA + kstep, voffA); G_STAGE(G_SB(1, 1), cB + hB + kstep, voffB);
  WAIT_V(6); BAR;
  for (int t = 0; t < nt - 2; t += 2) {
    const char* a1 = cA + (size_t)(t + 1) * kstep;
    const char* a2 = cA + (size_t)(t + 2) * kstep;
    const char* b2 = cB + (size_t)(t + 2) * kstep;
    const char* a3 = a2 + kstep;
    const char* b3 = b2 + kstep;
    G_LDB(B0, 0, 0); SCHED; G_LDA(At, 0, 0); G_STAGE(G_SA(1, 1), a1 + hA, voffA);
    WAIT_L(8); BAR; WAIT_L(0); G_MMA(0, 0, At, B0); BAR; SCHED;
    G_LDB(B1, 0, 1); G_STAGE(G_SB(0, 0), b2, voffB);
    BAR; WAIT_L(0); G_MMA(0, 1, At, B1); BAR;
    G_LDA(At, 0, 1); G_STAGE(G_SA(0, 0), a2, voffA);
    BAR; WAIT_L(0); G_MMA(1, 0, At, B0); BAR; SCHED;
    G_STAGE(G_SB(0, 1), b2 + hB, voffB);
    WAIT_V(6); BAR; G_MMA(1, 1, At, B1); BAR;
    G_LDB(B0, 1, 0); SCHED; G_LDA(At, 1, 0); G_STAGE(G_SA(0, 1), a2 + hA, voffA);
    WAIT_L(8); BAR; WAIT_L(0); G_MMA(0, 0, At, B0); BAR; SCHED;
    G_LDB(B1, 1, 1); G_STAGE(G_SB(1, 0), b3, voffB);
    BAR; WAIT_L(0); G_MMA(0, 1, At, B1); BAR;
    G_LDA(At, 1, 1); G_STAGE(G_SA(1, 0), a3, voffA);
    BAR; WAIT_L(0); G_MMA(1, 0, At, B0); BAR; SCHED;
    G_STAGE(G_SB(1, 1), b3 + hB, voffB);
    WAIT_V(6); BAR; G_MMA(1, 1, At, B1); BAR;
  }
  {
    const char* a1 = cA + (size_t)(nt - 1) * kstep;
    G_LDB(B0, 0, 0); G_LDA(At, 0, 0); G_STAGE(G_SA(1, 1), a1 + hA, voffA);
    BAR; WAIT_L(0); G_MMA(0, 0, At, B0); BAR;
    G_LDB(B1, 0, 1); BAR; WAIT_L(0); G_MMA(0, 1, At, B1); BAR;
    G_LDA(At, 0, 1); WAIT_V(4); BAR; WAIT_L(0); G_MMA(1, 0, At, B0); G_MMA(1, 1, At, B1); BAR;
  }
  {
    G_LDB(B0, 1, 0); G_LDA(At, 1, 0); WAIT_V(2); BAR; WAIT_L(0); G_MMA(0, 0, At, B0); BAR;
    G_LDB(B1, 1, 1); WAIT_V(0); BAR; WAIT_L(0); G_MMA(0, 1, At, B1); BAR;
    G_LDA(At, 1, 1); BAR; WAIT_L(0); G_MMA(1, 0, At, B0); G_MMA(1, 1, At, B1); BAR;
  }
  if (wr == 0) BAR;
}
__device__ __forceinline__ int xcd_first_tile() {
  const int bx = opaque_s((int)blockIdx.x), G = (int)gridDim.x;
  return (G & 7) ? bx : (bx & 7) * (G >> 3) + (bx >> 3);
}
template <class F>
__device__ __forceinline__ void epi256(Acc256& acc, F f) {
  const int tidx = opaque(threadIdx.x);
  const int wid = tidx >> 6, lane = tidx & 63, wr = wid >> 2, wc = wid & 3, fr = lane & 15, fq = lane >> 4;
#pragma unroll
  for (int ai = 0; ai < 2; ++ai)
#pragma unroll
    for (int bj = 0; bj < 2; ++bj)
#pragma unroll
      for (int m = 0; m < 4; ++m)
#pragma unroll
        for (int n = 0; n < 2; ++n) f(ai * 128 + wr * 64 + m * 16 + fq * 4, bj * 128 + wc * 32 + n * 16 + fr, acc[ai][bj][m][n]);
}

template <class AF>
struct TileLd {
  static constexpr int BK = 64, CPR = 8, NCH = 2, LDR = BK + 8;
  AF f;
  int t;
  uint4 r[NCH];
  __device__ __forceinline__ TileLd(AF f_) : f(f_), t(opaque(threadIdx.x)) {}
  __device__ __forceinline__ void load(int kt) {
#pragma unroll
    for (int i = 0; i < NCH; ++i) {
      const int ci = t + NTH * i, row = ci / CPR, c8 = ci % CPR;
      const u16* p = (const u16*)f(row, kt, c8);
      r[i] = p ? *(const uint4*)p : make_uint4(0, 0, 0, 0);
    }
  }
  __device__ __forceinline__ void store(char* dst) {
#pragma unroll
    for (int i = 0; i < NCH; ++i) {
      const int ci = t + NTH * i, row = ci / CPR, c8 = ci % CPR;
      *(uint4*)(dst + (row * LDR + c8 * 8) * 2) = r[i];
    }
  }
};
template <class LA, class LB>
__device__ __forceinline__ void gemm_loop(f32x4 (&acc)[2][4], LA& la, LB& lb, int nk, char* smem) {
  constexpr int BK = 64, LDR = BK + 8, TILE = 128 * LDR * 2, STAGE = 2 * TILE;
  const int tid = opaque(threadIdx.x), lane = tid & 63, wid = tid >> 6, wr = wid >> 1, wc = wid & 1, fr = lane & 15, fq = lane >> 4;
  la.load(0);
  lb.load(0);
  __syncthreads();
  la.store(smem);
  lb.store(smem + TILE);
  __syncthreads();
  for (int kt = 0; kt < nk; ++kt) {
    char* st = smem + (kt & 1) * STAGE;
    if (kt + 1 < nk) {
      la.load(kt + 1);
      lb.load(kt + 1);
    }
#pragma unroll
    for (int ks = 0; ks < 2; ++ks) {
      bf16x8 a[2], b[4];
#pragma unroll
      for (int m = 0; m < 2; ++m) a[m] = *(const bf16x8*)(st + ((wr * 32 + m * 16 + fr) * LDR + ks * 32 + fq * 8) * 2);
#pragma unroll
      for (int n = 0; n < 4; ++n) b[n] = *(const bf16x8*)(st + TILE + ((wc * 64 + n * 16 + fr) * LDR + ks * 32 + fq * 8) * 2);
#pragma unroll
      for (int m = 0; m < 2; ++m)
#pragma unroll
        for (int n = 0; n < 4; ++n) acc[m][n] = mfma16(a[m], b[n], acc[m][n]);
    }
    if (kt + 1 < nk) {
      char* sn = smem + ((kt + 1) & 1) * STAGE;
      la.store(sn);
      lb.store(sn + TILE);
    }
    __syncthreads();
  }
}
__device__ __forceinline__ void zero_acc(f32x4 (&acc)[2][4]) {
#pragma unroll
  for (int m = 0; m < 2; ++m)
#pragma unroll
    for (int n = 0; n < 4; ++n) acc[m][n] = f32x4{0.f, 0.f, 0.f, 0.f};
}
template <class F>
__device__ __forceinline__ void epi_each(f32x4 (&acc)[2][4], F f) {
  const int tid_ = opaque(threadIdx.x);
  const int lane = tid_ & 63, wid = tid_ >> 6, wr = wid >> 1, wc = wid & 1, fr = lane & 15, fq = lane >> 4;
#pragma unroll
  for (int m = 0; m < 2; ++m)
#pragma unroll
    for (int n = 0; n < 4; ++n) f(wr * 32 + m * 16 + fq * 4, wc * 64 + n * 16 + fr, acc[m][n]);
}
struct RowMajor {
  const u16* base;
  size_t ld;
  __device__ __forceinline__ const void* operator()(int row, int kt, int c8) const { return base + (size_t)row * ld + (size_t)kt * 64 + c8 * 8; }
};

template <class RM>
__device__ __forceinline__ void tr_tile(const float* src, int ldsrc, int C, u16* dhi, u16* dlo, int ldd, RM rm, int tr, int tc, float* sm) {
  const int t = opaque(threadIdx.x);
  const int r0 = tr * 64, c0 = tc * 64;
  __syncthreads();
  {
    const int c = t & 63;
#pragma unroll
    for (int i = 0; i < 8; ++i) {
      const int r = (t >> 6) + 8 * i;
      sm[r * 65 + c] = (c0 + c < C) ? src[(size_t)(r0 + r) * ldsrc + c0 + c] : 0.f;
    }
  }
  __syncthreads();
  {
    const int r = t & 63;
#pragma unroll
    for (int i = 0; i < 8; ++i) {
      const int c = (t >> 6) + 8 * i;
      if (c0 + c < C) {
        const int row = rm(c0 + c);
        const float v = sm[r * 65 + c];
        const u16 h = f2bf(v);
        dhi[(size_t)row * ldd + r0 + r] = h;
        if (dlo) dlo[(size_t)row * ldd + r0 + r] = f2bf(v - bf2f(h));
      }
    }
  }
}
struct RmId { __device__ int operator()(int c) const { return c; } };
struct RmIn {
  __device__ int operator()(int c) const {
    if (c < 384) return c;
    if (c < 640) return 512 + (c - 384);
    if (c < 704) return 384 + (c - 640);
    if (c < 720) return 448 + (c - 704);
    if (c < 1232) return 768 + (c - 720);
    if (c < 1744) return 1280 + (c - 1232);
    if (c < 2256) return 1792 + (c - 1744);
    return 2304 + (c - 2256);
  }
};
struct RmUp { __device__ int operator()(int c) const { return c < DFF ? ((c >> 7) * 256 + (c & 127)) : (((c - DFF) >> 7) * 256 + 128 + ((c - DFF) & 127)); } };

__device__ __forceinline__ void s5_pw(float lre, float lim, float step, int e, float& pr, float& pi) {
  const float a = (float)e * step;
  const float mag = __expf(a * lre);
  float rev = a * lim * 0.15915494309189535f;
  rev -= floorf(rev);
  const float ang = rev * 6.283185307179586f;
  pr = mag * __cosf(ang);
  pi = mag * __sinf(ang);
}
__device__ __forceinline__ void s5_bbar(float lre, float lim, float step, float br, float bi, float& or_, float& oi) {
  float pr, pi;
  s5_pw(lre, lim, step, 1, pr, pi);
  const float nr = pr - 1.f, ni = pi;
  const float den = lre * lre + lim * lim;
  const float qr = (nr * lre + ni * lim) / den, qi = (ni * lre - nr * lim) / den;
  or_ = qr * br - qi * bi;
  oi = qr * bi + qi * br;
}

__device__ __forceinline__ void phase_prep(const P& p, int l, char* smem) {
  char* ws = opaque_p(p.ws);
  float* sm = (float*)smem;
  const float* w_in = p.in(2) + (size_t)l * DM * INW;
  const float* w_uq = p.in(5) + (size_t)l * 384 * 512;
  const float* w_qidx = p.in(8) + (size_t)l * 384 * 1024;
  const float* w_glu = p.in(17) + (size_t)l * 512 * 512;
  const float* w_br = p.in(19) + (size_t)l * 3 * 512 * DM;
  const float* w_out = p.in(20) + (size_t)l * DM * DM;
  const float* w_up = p.in(23) + (size_t)l * DM * 2 * DFF;
  const float* w_down = p.in(26) + (size_t)l * DFF * DM;
  const int n1 = 32 * 44, n2 = 32 * 96, n3 = 6 * 8, n4 = 6 * 16, n5 = 8 * 8, n6 = 3 * 8 * 32, n7 = 32 * 32, n8 = 32 * 176, n9 = 88 * 32;
  const int ntot = n1 + n2 + n3 + n4 + n5 + n6 + n7 + n8 + n9;
  for (int it = opaque_s((int)blockIdx.x); it < ntot; it += gridDim.x) {
    int i = it;
    if (i < n1) { tr_tile(w_in, INW, NA, (u16*)(ws + O_WINHI), NOSPLIT ? nullptr : (u16*)(ws + O_WINLO), DM, RmIn(), i / 44, i % 44, sm); continue; }
    i -= n1;
    if (i < n2) { tr_tile(w_in + NA, INW, 6144, (u16*)(ws + O_WG), nullptr, DM, RmId(), i / 96, i % 96, sm); continue; }
    i -= n2;
    if (i < n3) { tr_tile(w_uq, 512, 512, (u16*)(ws + O_WQHI), NOSPLIT ? nullptr : (u16*)(ws + O_WQLO), 384, RmId(), i / 8, i % 8, sm); continue; }
    i -= n3;
    if (i < n4) { tr_tile(w_qidx, 1024, 1024, (u16*)(ws + O_WQHI) + 512 * 384, NOSPLIT ? nullptr : (u16*)(ws + O_WQLO) + 512 * 384, 384, RmId(), i / 16, i % 16, sm); continue; }
    i -= n4;
    if (i < n5) { tr_tile(w_glu, 512, 512, (u16*)(ws + O_WGLU), nullptr, 512, RmId(), i / 8, i % 8, sm); continue; }
    i -= n5;
    if (i < n6) { const int br = i / 256, j = i % 256; tr_tile(w_br + (size_t)br * 512 * DM, DM, DM, (u16*)(ws + O_WBR) + (size_t)br * DM * 512, nullptr, 512, RmId(), j / 32, j % 32, sm); continue; }
    i -= n6;
    if (i < n7) { tr_tile(w_out, DM, DM, (u16*)(ws + O_WOUT), nullptr, DM, RmId(), i / 32, i % 32, sm); continue; }
    i -= n7;
    if (i < n8) { tr_tile(w_up, 2 * DFF, 2 * DFF, (u16*)(ws + O_WUP), nullptr, DM, RmUp(), i / 176, i % 176, sm); continue; }
    i -= n8;
    { tr_tile(w_down, DM, DM, (u16*)(ws + O_WDOWN), nullptr, DFF, RmId(), i / 32, i % 32, sm); }
  }
  const int gtid = opaque_s((int)blockIdx.x) * NTH + opaque(threadIdx.x), gsz = gridDim.x * NTH;
  for (int i = gtid; i < (NAP - NA) * DM; i += gsz) {
    ((u16*)(ws + O_WINHI))[(size_t)464 * DM + i] = 0;
    ((u16*)(ws + O_WINLO))[(size_t)464 * DM + i] = 0;
  }
  const float* w_uk = p.in(6) + (size_t)l * 256 * 512;
  for (int i = gtid; i < 256 * 512; i += gsz) ((u16*)(ws + O_WUK))[i] = f2bf(w_uk[i]);
  const float* w_uv = p.in(7) + (size_t)l * 256 * 512;
  for (int i = gtid; i < 8 * 64 * 256; i += gsz) {
    const int cp = i & 255, d = (i >> 8) & 63, h = i >> 14;
    const int s = cp >> 5, e = cp & 31, quad = e >> 3, j = e & 7;
    const int c = 32 * s + (j < 4 ? quad * 4 + j : 16 + quad * 4 + (j - 4));
    ((u16*)(ws + O_WUVP))[i] = f2bf(w_uv[(size_t)c * 512 + h * 64 + d]);
  }
  for (int i = gtid; i < 512 * 2048; i += gsz) {
    const int n = i >> 11, k = i & 2047, h = n >> 6, d = n & 63, kh = k >> 8, c = k & 255;
    ((u16*)(ws + O_WUVBD))[i] = (kh == h) ? f2bf(w_uv[(size_t)c * 512 + h * 64 + d]) : (u16)0;
  }
  const float* lam_re = p.in(9) + l * 32 * 64;
  const float* lam_im = p.in(10) + l * 32 * 64;
  const float* log_step = p.in(11) + l * 32;
  const float* b_re = p.in(12) + (size_t)l * 32 * 64 * 16;
  const float* b_im = p.in(13) + (size_t)l * 32 * 64 * 16;
  const float* c_re = p.in(14) + (size_t)l * 32 * 16 * 64;
  const float* c_im = p.in(15) + (size_t)l * 32 * 16 * 64;
  for (int i = gtid; i < 32 * 32 * 16; i += gsz) {
    const int po = i & 15, dl = (i >> 4) & 31, g = i >> 9;
    const float step = __expf(log_step[g]);
    float acc16[16];
#pragma unroll
    for (int k = 0; k < 16; ++k) acc16[k] = 0.f;
    for (int n = 0; n < 64; ++n) {
      const float lre = lam_re[g * 64 + n], lim = lam_im[g * 64 + n];
      float pr, pim, qr, qi;
      s5_pw(lre, lim, step, dl, pr, pim);
      s5_bbar(lre, lim, step, 1.f, 0.f, qr, qi);
      const float wr_ = pr * qr - pim * qi, wi_ = pr * qi + pim * qr;
      const float cr = c_re[(g * 16 + po) * 64 + n], ci = c_im[(g * 16 + po) * 64 + n];
      const float er = cr * wr_ - ci * wi_, ei = cr * wi_ + ci * wr_;
      const float4* br4 = (const float4*)(b_re + (g * 64 + n) * 16);
      const float4* bi4 = (const float4*)(b_im + (g * 64 + n) * 16);
#pragma unroll
      for (int k = 0; k < 4; ++k) {
        const float4 br = br4[k], bi = bi4[k];
        acc16[4 * k + 0] += er * br.x - ei * bi.x;
        acc16[4 * k + 1] += er * br.y - ei * bi.y;
        acc16[4 * k + 2] += er * br.z - ei * bi.z;
        acc16[4 * k + 3] += er * br.w - ei * bi.w;
      }
    }
    u16* dst = (u16*)(ws + O_KTAB) + (size_t)i * 16;
#pragma unroll
    for (int k = 0; k < 16; ++k) dst[k] = f2bf(acc16[k]);
  }
  for (int i = gtid; i < 32 * 512 * 128; i += gsz) {
    const int col = i & 127, row = (i >> 7) & 511, g = i >> 16;
    const int n = col & 63, ii = row >> 4, po = row & 15;
    const float step = __expf(log_step[g]);
    float pr, pim;
    s5_pw(lam_re[g * 64 + n], lam_im[g * 64 + n], step, ii + 1, pr, pim);
    const float cr = c_re[(g * 16 + po) * 64 + n], ci = c_im[(g * 16 + po) * 64 + n];
    const float v = (col < 64) ? (cr * pr - ci * pim) : -(cr * pim + ci * pr);
    ((u16*)(ws + O_CM))[i] = f2bf(v);
  }
  for (int i = gtid; i < 32 * 128 * 512; i += gsz) {
    const int k = i & 511, row = (i >> 9) & 127, g = i >> 16;
    const int n = row & 63, j = k >> 4, pi_ = k & 15;
    const float step = __expf(log_step[g]);
    const float lre = lam_re[g * 64 + n], lim = lam_im[g * 64 + n];
    float pr, pim, bbr, bbi;
    s5_pw(lre, lim, step, 31 - j, pr, pim);
    s5_bbar(lre, lim, step, b_re[(g * 64 + n) * 16 + pi_], b_im[(g * 64 + n) * 16 + pi_], bbr, bbi);
    const float v = (row < 64) ? (pr * bbr - pim * bbi) : (pr * bbi + pim * bbr);
    ((u16*)(ws + O_BM))[i] = f2bf(v);
  }
  for (int i = gtid; i < 32 * 64; i += gsz) {
    const int g = i >> 6;
    float pr, pim;
    s5_pw(lam_re[i], lam_im[i], __expf(log_step[g]), 32, pr, pim);
    ((float2*)(ws + O_LAML))[i] = make_float2(pr, pim);
  }
  if (l == 0) {
    const float* rel = p.in(1);
    for (int i = gtid; i < 16 * 2048; i += gsz) {
      const int dist = i & 2047, hh = i >> 11;
      int bk;
      if (dist < 16) bk = dist;
      else {
        bk = 16 + (int)(__log2f((float)dist * 0.0625f) * (16.f / 3.f));
        if (bk > 31) bk = 31;
      }
      ((float*)(ws + O_BIASD))[i] = rel[bk * 16 + hh];
    }
    const float4* x4 = (const float4*)p.in(0);
    for (size_t i = gtid; i < (size_t)NTOK * DM / 4; i += gsz) {
      const float4 v = x4[i];
      const u16 h0 = f2bf(v.x), h1 = f2bf(v.y), h2 = f2bf(v.z), h3 = f2bf(v.w);
      ((uint2*)(ws + O_XH))[i] = make_uint2((uint32_t)h0 | ((uint32_t)h1 << 16), (uint32_t)h2 | ((uint32_t)h3 << 16));
      if (!NOSPLIT) ((uint2*)(ws + O_XL))[i] = make_uint2(pack2(v.x - bf2f(h0), v.y - bf2f(h1)), pack2(v.z - bf2f(h2), v.w - bf2f(h3)));
    }
  }
}

__device__ __forceinline__ void phase_gemm_in(const P& p, char* smem) {
  char* ws = opaque_p(p.ws);
  const int ntiles = 128 * 11;
  for (int it = xcd_first_tile(); it < ntiles; it += gridDim.x) {
    const int mb = it / 44, rem = it - mb * 44, tn = rem >> 2, tm = mb * 4 + (rem & 3);
    Acc256 acc;
    zero256(acc);
    const u16* ah = (const u16*)(ws + O_XH) + (size_t)tm * 256 * DM;
    const u16* al = (const u16*)(ws + O_XL) + (size_t)tm * 256 * DM;
    const u16* bh = (const u16*)(ws + O_WINHI) + (size_t)tn * 256 * DM;
    const u16* bl = (const u16*)(ws + O_WINLO) + (size_t)tn * 256 * DM;
    if (NOSPLIT == 0 && tn < 2) {
      gemm256(acc, al, DM, bh, DM, DM, smem);
      gemm256(acc, ah, DM, bl, DM, DM, smem);
    }
    gemm256(acc, ah, DM, bh, DM, DM, smem);
    const int m0 = tm * 256, n0 = tn * 256;
    epi256(acc, [&](int lr, int lc, f32x4 v) {
      const int col = n0 + lc;
      const int t0 = m0 + lr;
      if (col < 384) {
        float* d = (float*)(ws + O_CQ);
#pragma unroll
        for (int r = 0; r < 4; ++r) d[(size_t)(t0 + r) * 384 + col] = v[r];
      } else if (col < 448) {
        float* d = (float*)(ws + O_KIDX);
#pragma unroll
        for (int r = 0; r < 4; ++r) d[(size_t)(t0 + r) * 64 + col - 384] = v[r];
      } else if (col < 464) {
        float* d = (float*)(ws + O_WIDX);
#pragma unroll
        for (int r = 0; r < 4; ++r) d[(size_t)(t0 + r) * 16 + col - 448] = v[r];
      } else if (col < 512) {
      } else if (col < 768) {
        float* d = (float*)(ws + O_CKV);
#pragma unroll
        for (int r = 0; r < 4; ++r) d[(size_t)(t0 + r) * 256 + col - 512] = v[r];
      } else if (col < 1280) {
        u16* d = (u16*)(ws + O_U);
#pragma unroll
        for (int r = 0; r < 4; ++r) d[(size_t)(t0 + r) * 512 + col - 768] = f2bf(v[r]);
      } else if (col < 1792) {
        float* d = (float*)(ws + O_QC);
#pragma unroll
        for (int r = 0; r < 4; ++r) d[(size_t)(t0 + r) * 512 + col - 1280] = v[r];
      } else if (col < 2304) {
        float* d = (float*)(ws + O_KC);
        u16* d2 = (u16*)(ws + O_KCB);
#pragma unroll
        for (int r = 0; r < 4; ++r) {
          d[(size_t)(t0 + r) * 512 + col - 1792] = v[r];
          d2[(size_t)(t0 + r) * 512 + col - 1792] = f2bf(v[r]);
        }
      } else {
        const int c = col - 2304, h = c >> 6, dd = c & 63, b = t0 >> 11, tt = t0 & 2047;
        u16* d = (u16*)(ws + O_VT) + ((size_t)((b * 8 + h) * 64 + dd)) * T + tt;
        *(uint2*)d = make_uint2(pack2(v[0], v[1]), pack2(v[2], v[3]));
      }
    });
  }
}

struct S5UAddr {
  const u16* base;
  int row0;
  __device__ __forceinline__ const void* operator()(int row, int kt, int c8) const {
    const int rc = row0 + row;
    const int j = kt * 4 + (c8 >> 1), pi0 = (c8 & 1) * 8;
    return base + ((size_t)rc * 32 + j) * 512 + pi0;
  }
};
struct S5ToepAddr {
  const u16* ktab;
  int n0;
  __device__ __forceinline__ const void* operator()(int row, int kt, int c8) const {
    const int n = n0 + row, i = n >> 4, po = n & 15;
    const int j = kt * 4 + (c8 >> 1), pi0 = (c8 & 1) * 8;
    if (j > i) return nullptr;
    return ktab + ((i - j) * 16 + po) * 16 + pi0;
  }
};

__device__ __forceinline__ void phase_p2(const P& p, int l, char* smem) {
  char* ws = opaque_p(p.ws);
  const int tid = opaque(threadIdx.x), lane = tid & 63, wid = tid >> 6;
  const float* cq_gain = p.in(3) + l * 384;
  const float* ckv_gain = p.in(4) + l * 256;
  const int n_tok = NTOK / 64, n_km = 16 * 8 * 8, n_g1 = 32 * 8;
  for (int it = opaque_s((int)blockIdx.x); it < n_tok + n_km + n_g1; it += gridDim.x) {
    if (it < n_tok) {
      const int b = it >> 5, tc = it & 31, t0g = b * T + tc * 64;
      u16* sT = (u16*)smem;
      __syncthreads();
      for (int i = 0; i < 8; ++i) {
        const int tl = wid * 8 + i, t = t0g + tl;
        {
          const float* src = (const float*)(ws + O_CQ) + (size_t)t * 384;
          float v[6], ss = 0.f;
#pragma unroll
          for (int j = 0; j < 6; ++j) { v[j] = src[lane + 64 * j]; ss += v[j] * v[j]; }
          ss = wave_sum(ss);
          const float rs = rsqrtf(ss * (1.f / 384.f) + 1e-5f);
#pragma unroll
          for (int j = 0; j < 6; ++j) {
            const float y = v[j] * rs * cq_gain[lane + 64 * j];
            const u16 h = f2bf(y);
            ((u16*)(ws + O_CQNHI))[(size_t)t * 384 + lane + 64 * j] = h;
            if (!NOSPLIT) ((u16*)(ws + O_CQNLO))[(size_t)t * 384 + lane + 64 * j] = f2bf(y - bf2f(h));
          }
        }
        {
          const float* src = (const float*)(ws + O_CKV) + (size_t)t * 256;
          float v[4], ss = 0.f;
#pragma unroll
          for (int j = 0; j < 4; ++j) { v[j] = src[lane + 64 * j]; ss += v[j] * v[j]; }
          ss = wave_sum(ss);
          const float rs = rsqrtf(ss * (1.f / 256.f) + 1e-5f);
#pragma unroll
          for (int j = 0; j < 4; ++j) {
            const u16 h = f2bf(v[j] * rs * ckv_gain[lane + 64 * j]);
            ((u16*)(ws + O_CKVN))[(size_t)t * 256 + lane + 64 * j] = h;
            sT[tl * 258 + lane + 64 * j] = h;
          }
        }
        {
          const float y = ((const float*)(ws + O_KIDX))[(size_t)t * 64 + lane];
          const u16 h = f2bf(y);
          ((u16*)(ws + O_KIHI))[(size_t)t * 64 + lane] = h;
          if (!NOSPLIT) ((u16*)(ws + O_KILO))[(size_t)t * 64 + lane] = f2bf(y - bf2f(h));
        }
      }
      __syncthreads();
      {
        const int c = tid & 255, half = tid >> 8;
        u16* dst = (u16*)(ws + O_CKVNT) + ((size_t)(b * 256 + c)) * T + tc * 64;
#pragma unroll
        for (int jj = 0; jj < 4; ++jj) {
          const int j = half * 4 + jj;
          U4 u;
#pragma unroll
          for (int e = 0; e < 8; ++e) u.s[e] = sT[(j * 8 + e) * 258 + c];
          *(uint4*)(dst + j * 8) = u.v;
        }
      }
    } else if (it < n_tok + n_km) {
      const int i = it - n_tok, h = i & 7, n = (i >> 3) & 7, b = i >> 6;
      float* sm = (float*)smem;
      const int d = tid & 63, tq = tid >> 6;
      const float* src = (const float*)(ws + O_KC) + ((size_t)(b * T + n * 256 + tq * 32)) * 512 + h * 64 + d;
      float s = 0.f;
      for (int j = 0; j < 32; ++j) s += src[(size_t)j * 512];
      __syncthreads();
      sm[tq * 64 + d] = s;
      __syncthreads();
      if (tid < 64) {
        float a = 0.f;
#pragma unroll
        for (int j = 0; j < 8; ++j) a += sm[j * 64 + tid];
        ((float*)(ws + O_KMEAN))[((b * 8 + n) * 8 + h) * 64 + tid] = a * (1.f / 256.f);
      }
    } else {
      const int i = it - n_tok - n_km, g = i >> 3, tm = i & 7;
      f32x4 acc[2][4];
      zero_acc(acc);
      S5UAddr fa{(const u16*)(ws + O_U) + g * 16, tm * 128};
      RowMajor fb{(const u16*)(ws + O_BM) + (size_t)g * 128 * 512, 512};
      TileLd<S5UAddr> la(fa);
      TileLd<RowMajor> lb(fb);
      gemm_loop(acc, la, lb, 8, smem);
      float* dst = (float*)(ws + O_SLOC) + (size_t)g * 1024 * 128;
      epi_each(acc, [&](int lr, int lc, f32x4 v) {
#pragma unroll
        for (int r = 0; r < 4; ++r) dst[(size_t)(tm * 128 + lr + r) * 128 + lc] = v[r];
      });
    }
  }
}

__device__ __forceinline__ void phase_p3(const P& p, char* smem) {
  char* ws = opaque_p(p.ws);
  const int tid = opaque(threadIdx.x);
  const int n_g = 128 * 6, n_gate = NTOK * 8 / NTH, n_scan = 32 * 16 * 64 / NTH;
  for (int it = opaque_s((int)blockIdx.x); it < n_g; it += gridDim.x) {
    {
      const int tn = it % 6, tm = it / 6;
      Acc256 acc;
      zero256(acc);
      const u16* ah = (const u16*)(ws + O_CQNHI) + (size_t)tm * 256 * 384;
      const u16* al = (const u16*)(ws + O_CQNLO) + (size_t)tm * 256 * 384;
      const u16* bh = (const u16*)(ws + O_WQHI) + (size_t)tn * 256 * 384;
      const u16* bl = (const u16*)(ws + O_WQLO) + (size_t)tn * 256 * 384;
      if (NOSPLIT == 0) {
        gemm256(acc, al, 384, bh, 384, 384, smem);
        gemm256(acc, ah, 384, bl, 384, 384, smem);
      }
      gemm256(acc, ah, 384, bh, 384, 384, smem);
      const int m0 = tm * 256, n0 = tn * 256;
      epi256(acc, [&](int lr, int lc, f32x4 v) {
        const int col = n0 + lc, t0 = m0 + lr;
        if (col < 512) {
#pragma unroll
          for (int r = 0; r < 4; ++r) ((u16*)(ws + O_Q))[(size_t)(t0 + r) * 512 + col] = f2bf(v[r]);
        } else {
#pragma unroll
          for (int r = 0; r < 4; ++r) {
            const float y = v[r] * 0.125f;
            const u16 h = f2bf(y);
            ((u16*)(ws + O_QIHI))[(size_t)(t0 + r) * 1024 + col - 512] = h;
            if (!NOSPLIT) ((u16*)(ws + O_QILO))[(size_t)(t0 + r) * 1024 + col - 512] = f2bf(y - bf2f(h));
          }
        }
      });
    }
  }
  for (int it = opaque_s((int)blockIdx.x); it < n_gate; it += gridDim.x) {
    {
      const int idx = it * NTH + tid;
      const int h = idx & 7, t = idx >> 3, b = t >> 11, own = (t & 2047) >> 8;
      const float4* q4 = (const float4*)((const float*)(ws + O_QC) + (size_t)t * 512 + h * 64);
      float v0 = -INFINITY, v1 = -INFINITY, v2 = -INFINITY;
      int i0 = -1, i1 = -1, i2 = -1;
      for (int n = 0; n < own; ++n) {
        const float4* k4 = (const float4*)((const float*)(ws + O_KMEAN) + ((b * 8 + n) * 8 + h) * 64);
        float s = 0.f;
#pragma unroll
        for (int j = 0; j < 16; ++j) {
          const float4 a = q4[j], c = k4[j];
          s += a.x * c.x + a.y * c.y + a.z * c.z + a.w * c.w;
        }
        if (s > v0) { v2 = v1; i2 = i1; v1 = v0; i1 = i0; v0 = s; i0 = n; }
        else if (s > v1) { v2 = v1; i2 = i1; v1 = s; i1 = n; }
        else if (s > v2) { v2 = s; i2 = n; }
      }
      unsigned m = 0;
      if (i0 >= 0) m |= 1u << i0;
      if (i1 >= 0) m |= 1u << i1;
      if (i2 >= 0) m |= 1u << i2;
      ((unsigned char*)(ws + O_MSEL))[idx] = (unsigned char)m;
    }
  }
  for (int it = opaque_s((int)blockIdx.x); it < n_scan; it += gridDim.x) {
    {
      const int idx = it * NTH + tid;
      const int n = idx & 63, b = (idx >> 6) & 15, g = idx >> 10;
      const float2 lm = ((const float2*)(ws + O_LAML))[g * 64 + n];
      const float* sl = (const float*)(ws + O_SLOC) + ((size_t)g * 1024 + b * 64) * 128;
      u16* sp = (u16*)(ws + O_SPREV) + ((size_t)g * 1024 + b * 64) * 128;
      float sr = 0.f, si = 0.f;
      for (int c = 0; c < 64; ++c) {
        sp[c * 128 + n] = f2bf(sr);
        sp[c * 128 + 64 + n] = f2bf(si);
        const float ar = sl[c * 128 + n], ai = sl[c * 128 + 64 + n];
        const float nr = lm.x * sr - lm.y * si + ar, ni = lm.x * si + lm.y * sr + ai;
        sr = nr;
        si = ni;
      }
    }
  }
}

template <bool DSA>
__device__ __forceinline__ void attn_item(const P& p, int b, int qb, int h, char* smem) {
  constexpr int DK = DSA ? 256 : 64, DVP = DSA ? 128 : 64, NPASS = DSA ? 2 : 1, KS = DK / 32, LDK = DK + 8, LDV = 64 + 8, NMT = DVP / 16;
  constexpr int NKC = 64 * DK / 8 / NTH;
  constexpr int NVC = DVP * 8 / NTH;
  char* ws = opaque_p(p.ws);
  const int tid = opaque(threadIdx.x), lane = tid & 63, wid = tid >> 6, fr = lane & 15, fq = lane >> 4;
  u16* Ks = (u16*)smem;
  u16* Vt = (u16*)(smem + 64 * LDK * 2);
  float* bias = (float*)(smem + 64 * LDK * 2 + DVP * LDV * 2);
  const int q0 = qb * 128, qpos = q0 + wid * 16 + fr;
  const size_t tq = (size_t)b * T + qpos;
  __syncthreads();
  {
    const float* bsrc = (const float*)(ws + O_BIASD) + (size_t)(DSA ? h : 8 + h) * 2048;
    for (int i = tid; i < 2048; i += NTH) bias[i] = bsrc[i];
  }
  bf16x8 qf[KS];
  if (DSA) {
    const u16* wuk = (const u16*)(ws + O_WUK);
    const u16* qsrc = (const u16*)(ws + O_Q) + tq * 512 + h * 64;
    U4 qb0, qb1;
    qb0.v = *(const uint4*)(qsrc + fq * 8);
    qb1.v = *(const uint4*)(qsrc + 32 + fq * 8);
#pragma unroll
    for (int s = 0; s < 8; ++s) {
      f32x4 a0 = {0.f, 0.f, 0.f, 0.f}, a1 = {0.f, 0.f, 0.f, 0.f};
      {
        const u16* w0 = wuk + ((size_t)(32 * s + fr) * 8 + h) * 64;
        const u16* w1 = wuk + ((size_t)(32 * s + 16 + fr) * 8 + h) * 64;
        U4 x0, x1, y0, y1;
        x0.v = *(const uint4*)(w0 + fq * 8);
        x1.v = *(const uint4*)(w0 + 32 + fq * 8);
        y0.v = *(const uint4*)(w1 + fq * 8);
        y1.v = *(const uint4*)(w1 + 32 + fq * 8);
        a0 = mfma16(x0.h, qb0.h, a0);
        a0 = mfma16(x1.h, qb1.h, a0);
        a1 = mfma16(y0.h, qb0.h, a1);
        a1 = mfma16(y1.h, qb1.h, a1);
      }
      U4 o;
      o.w[0] = pack2(a0[0] * 0.125f, a0[1] * 0.125f);
      o.w[1] = pack2(a0[2] * 0.125f, a0[3] * 0.125f);
      o.w[2] = pack2(a1[0] * 0.125f, a1[1] * 0.125f);
      o.w[3] = pack2(a1[2] * 0.125f, a1[3] * 0.125f);
      qf[s] = o.h;
      __builtin_amdgcn_sched_barrier(0);
    }
  } else {
    const float* qsrc = (const float*)(ws + O_QC) + tq * 512 + h * 64;
#pragma unroll
    for (int s = 0; s < KS; ++s) {
      const float4 a = *(const float4*)(qsrc + 32 * s + fq * 8), c = *(const float4*)(qsrc + 32 * s + fq * 8 + 4);
      U4 o;
      o.w[0] = pack2(a.x * 0.125f, a.y * 0.125f);
      o.w[1] = pack2(a.z * 0.125f, a.w * 0.125f);
      o.w[2] = pack2(c.x * 0.125f, c.y * 0.125f);
      o.w[3] = pack2(c.z * 0.125f, c.w * 0.125f);
      qf[s] = o.h;
    }
  }
  unsigned msel = 0;
  const uint32_t* mrow = nullptr;
  if (DSA) mrow = (const uint32_t*)(ws + O_MASK) + tq * 64;
  else msel = ((const unsigned char*)(ws + O_MSEL))[tq * 8 + h];
  const int ownblk = q0 >> 8;
  const u16* kg = DSA ? (const u16*)(ws + O_CKVN) + (size_t)b * T * 256 : (const u16*)(ws + O_KCB) + (size_t)b * T * 512 + h * 64;
  const int kld = DSA ? 256 : 512;
  const int nkt = 2 * qb + 2;
  f32x4 oo[4];
#pragma unroll
  for (int i = 0; i < 4; ++i) oo[i] = f32x4{0.f, 0.f, 0.f, 0.f};

#pragma unroll 1
  for (int pass = 0; pass < NPASS; ++pass) {
    const u16* vg = DSA ? (const u16*)(ws + O_CKVNT) + ((size_t)b * 256 + pass * 128) * T : (const u16*)(ws + O_VT) + (size_t)(b * 8 + h) * 64 * T;
    f32x4 ot[NMT];
#pragma unroll
    for (int i = 0; i < NMT; ++i) ot[i] = f32x4{0.f, 0.f, 0.f, 0.f};
    float m_run = -1e30f, l_run = 0.f;
    uint4 k0 = make_uint4(0, 0, 0, 0), k1 = k0, k2 = k0, k3 = k0, v0 = k0, v1 = k0;
#define KADDR(i, ktt) (kg + (size_t)((ktt) * 64 + (tid + NTH * (i)) / (DK / 8)) * kld + ((tid + NTH * (i)) % (DK / 8)) * 8)
#define VADDR(i, ktt) (vg + (size_t)((tid + NTH * (i)) >> 3) * T + (ktt) * 64 + ((tid + NTH * (i)) & 7) * 8)
#define KSADDR(i) (Ks + ((tid + NTH * (i)) / (DK / 8)) * LDK + ((tid + NTH * (i)) % (DK / 8)) * 8)
#define VSADDR(i) (Vt + ((tid + NTH * (i)) >> 3) * LDV + ((tid + NTH * (i)) & 7) * 8)
#define TILE_LOAD(ktt)                                          \
  do {                                                          \
    k0 = *(const uint4*)KADDR(0, ktt);                          \
    if (NKC > 1) k1 = *(const uint4*)KADDR(1, ktt);             \
    if (NKC > 2) k2 = *(const uint4*)KADDR(2, ktt);             \
    if (NKC > 3) k3 = *(const uint4*)KADDR(3, ktt);             \
    v0 = *(const uint4*)VADDR(0, ktt);                          \
    if (NVC > 1) v1 = *(const uint4*)VADDR(1, ktt);             \
  } while (0)
    TILE_LOAD(0);
#pragma unroll 1
    for (int kt = 0; kt < nkt; ++kt) {
      __syncthreads();
      *(uint4*)KSADDR(0) = k0;
      if (NKC > 1) *(uint4*)KSADDR(1) = k1;
      if (NKC > 2) *(uint4*)KSADDR(2) = k2;
      if (NKC > 3) *(uint4*)KSADDR(3) = k3;
      *(uint4*)VSADDR(0) = v0;
      if (NVC > 1) *(uint4*)VSADDR(1) = v1;
      __syncthreads();
      if (kt + 1 < nkt) TILE_LOAD(kt + 1);
      f32x4 st[4];
#pragma unroll
      for (int m = 0; m < 4; ++m) {
        st[m] = f32x4{0.f, 0.f, 0.f, 0.f};
        const u16* krow = Ks + (16 * m + fr) * LDK;
#pragma unroll
        for (int s = 0; s < KS; ++s) {
          U4 a;
          if (DSA) {
            const uint2 x = *(const uint2*)(krow + 32 * s + fq * 4), y = *(const uint2*)(krow + 32 * s + 16 + fq * 4);
            a.w[0] = x.x; a.w[1] = x.y; a.w[2] = y.x; a.w[3] = y.y;
          } else {
            a.v = *(const uint4*)(krow + 32 * s + fq * 8);
          }
          st[m] = mfma16(a.h, qf[s], st[m]);
        }
        __builtin_amdgcn_sched_barrier(0);
      }
      uint32_t mw0 = 0, mw1 = 0;
      bool blk_ok = false;
      const int kblk = kt >> 2;
      if (DSA) { const uint2 mm = *(const uint2*)(mrow + 2 * kt); mw0 = mm.x; mw1 = mm.y; }
      else blk_ok = (kblk < ownblk) ? ((msel >> kblk) & 1u) : true;
      float mx = m_run;
      unsigned okm = 0;
#pragma unroll
      for (int m = 0; m < 4; ++m)
#pragma unroll
        for (int r = 0; r < 4; ++r) {
          const int kl = 16 * m + fq * 4 + r, key = kt * 64 + kl;
          bool a;
          if (DSA) a = (((m < 2 ? mw0 : mw1) >> ((m & 1) * 16 + fq * 4 + r)) & 1u) != 0;
          else a = blk_ok && (key <= qpos);
          if (a) okm |= 1u << (m * 4 + r);
          const int dist = qpos - key;
          const float s = st[m][r] + bias[dist < 0 ? 0 : dist];
          st[m][r] = s;
          if (a) mx = fmaxf(mx, s);
        }
      mx = fmaxf(mx, __shfl_xor(mx, 16));
      mx = fmaxf(mx, __shfl_xor(mx, 32));
      const float alpha = __expf(m_run - mx);
      float ls = 0.f;
#pragma unroll
      for (int m = 0; m < 4; ++m)
#pragma unroll
        for (int r = 0; r < 4; ++r) {
          const float pv = ((okm >> (m * 4 + r)) & 1u) ? __expf(st[m][r] - mx) : 0.f;
          st[m][r] = pv;
          ls += pv;
        }
      l_run = l_run * alpha + ls;
      m_run = mx;
#pragma unroll
      for (int i = 0; i < NMT; ++i) ot[i] *= alpha;
#pragma unroll
      for (int s = 0; s < 2; ++s) {
        U4 pb;
        pb.w[0] = pack2(st[2 * s][0], st[2 * s][1]);
        pb.w[1] = pack2(st[2 * s][2], st[2 * s][3]);
        pb.w[2] = pack2(st[2 * s + 1][0], st[2 * s + 1][1]);
        pb.w[3] = pack2(st[2 * s + 1][2], st[2 * s + 1][3]);
#pragma unroll
        for (int mt = 0; mt < NMT; ++mt) {
          const u16* vrow = Vt + (16 * mt + fr) * LDV + 32 * s;
          const uint2 x = *(const uint2*)(vrow + fq * 4), y = *(const uint2*)(vrow + 16 + fq * 4);
          U4 a;
          a.w[0] = x.x; a.w[1] = x.y; a.w[2] = y.x; a.w[3] = y.y;
          ot[mt] = mfma16(a.h, pb.h, ot[mt]);
          if ((mt & 3) == 3) __builtin_amdgcn_sched_barrier(0);
        }
      }
    }
    l_run += __shfl_xor(l_run, 16);
    l_run += __shfl_xor(l_run, 32);
    const float inv = 1.f / l_run;
    if (DSA) {
      const u16* wv = (const u16*)(ws + O_WUVP) + (size_t)h * 64 * 256 + pass * 128;
#pragma unroll
      for (int s = 0; s < 4; ++s) {
        U4 pb;
        pb.w[0] = pack2(ot[2 * s][0] * inv, ot[2 * s][1] * inv);
        pb.w[1] = pack2(ot[2 * s][2] * inv, ot[2 * s][3] * inv);
        pb.w[2] = pack2(ot[2 * s + 1][0] * inv, ot[2 * s + 1][1] * inv);
        pb.w[3] = pack2(ot[2 * s + 1][2] * inv, ot[2 * s + 1][3] * inv);
#pragma unroll
        for (int mt = 0; mt < 4; ++mt) {
          U4 a;
          a.v = *(const uint4*)(wv + (size_t)(16 * mt + fr) * 256 + 32 * s + fq * 8);
          oo[mt] = mfma16(a.h, pb.h, oo[mt]);
        }
        __builtin_amdgcn_sched_barrier(0);
      }
    } else {
      u16* dst = (u16*)(ws + O_OC) + tq * 512 + h * 64;
#pragma unroll
      for (int mt = 0; mt < NMT; ++mt)
        *(uint2*)(dst + 16 * mt + fq * 4) = make_uint2(pack2(ot[mt][0] * inv, ot[mt][1] * inv), pack2(ot[mt][2] * inv, ot[mt][3] * inv));
    }
  }
  if (DSA) {
    u16* dst = (u16*)(ws + O_OA) + tq * 512 + h * 64;
#pragma unroll
    for (int mt = 0; mt < 4; ++mt) *(uint2*)(dst + 16 * mt + fq * 4) = make_uint2(pack2(oo[mt][0], oo[mt][1]), pack2(oo[mt][2], oo[mt][3]));
  }
}


__device__ __forceinline__ void dsa_item(const P& p, int b, int qb32, char* smem) {
  constexpr int LDK = 264, LDV = 72;
  char* ws = opaque_p(p.ws);
  const int tid = opaque(threadIdx.x), lane = tid & 63, h = tid >> 6, fr = lane & 15, fq = lane >> 4;
  u16* Ks = (u16*)smem;
  u16* Vt = (u16*)(smem + 33792);
  const float* bias = (const float*)(smem + 52224) + h * 2048;
  const int q0 = qb32 * 32;
  const int qpos0 = q0 + fr, qpos1 = q0 + 16 + fr;
  const size_t tq0 = (size_t)b * T + qpos0, tq1 = tq0 + 16;
  bf16x8 qf0[8], qf1[8];
  {
    const u16* wuk = (const u16*)(ws + O_WUK);
    const u16* qs0 = (const u16*)(ws + O_Q) + tq0 * 512 + h * 64;
    const u16* qs1 = qs0 + 16 * 512;
    U4 qa0, qa1, qb0, qb1;
    qa0.v = *(const uint4*)(qs0 + fq * 8);
    qa1.v = *(const uint4*)(qs0 + 32 + fq * 8);
    qb0.v = *(const uint4*)(qs1 + fq * 8);
    qb1.v = *(const uint4*)(qs1 + 32 + fq * 8);
#pragma unroll
    for (int s = 0; s < 8; ++s) {
      f32x4 a0 = {0.f, 0.f, 0.f, 0.f}, a1 = a0, c0 = a0, c1 = a0;
      const u16* w0 = wuk + ((size_t)(32 * s + fr) * 8 + h) * 64;
      const u16* w1 = wuk + ((size_t)(32 * s + 16 + fr) * 8 + h) * 64;
      U4 x0, x1, y0, y1;
      x0.v = *(const uint4*)(w0 + fq * 8);
      x1.v = *(const uint4*)(w0 + 32 + fq * 8);
      y0.v = *(const uint4*)(w1 + fq * 8);
      y1.v = *(const uint4*)(w1 + 32 + fq * 8);
      a0 = mfma16(x0.h, qa0.h, a0); a0 = mfma16(x1.h, qa1.h, a0);
      a1 = mfma16(y0.h, qa0.h, a1); a1 = mfma16(y1.h, qa1.h, a1);
      c0 = mfma16(x0.h, qb0.h, c0); c0 = mfma16(x1.h, qb1.h, c0);
      c1 = mfma16(y0.h, qb0.h, c1); c1 = mfma16(y1.h, qb1.h, c1);
      U4 o;
      o.w[0] = pack2(a0[0] * 0.125f, a0[1] * 0.125f); o.w[1] = pack2(a0[2] * 0.125f, a0[3] * 0.125f);
      o.w[2] = pack2(a1[0] * 0.125f, a1[1] * 0.125f); o.w[3] = pack2(a1[2] * 0.125f, a1[3] * 0.125f);
      qf0[s] = o.h;
      o.w[0] = pack2(c0[0] * 0.125f, c0[1] * 0.125f); o.w[1] = pack2(c0[2] * 0.125f, c0[3] * 0.125f);
      o.w[2] = pack2(c1[0] * 0.125f, c1[1] * 0.125f); o.w[3] = pack2(c1[2] * 0.125f, c1[3] * 0.125f);
      qf1[s] = o.h;
      __builtin_amdgcn_sched_barrier(0);
    }
  }
  const char* mbase = ws + O_MASK + ((size_t)b * T + q0) * 256;
  const unsigned mvo = (unsigned)fr * 256u;
  const u16* kg = (const u16*)(ws + O_CKVN) + (size_t)b * T * 256;
  const int nkt = (q0 + 32 + 63) >> 6;
#pragma unroll 1
  for (int pass = 0; pass < 2; ++pass) {
    const u16* vg = (const u16*)(ws + O_CKVNT) + ((size_t)b * 256 + pass * 128) * T;
    f32x4 ot0[8], ot1[8];
#pragma unroll
    for (int i = 0; i < 8; ++i) { ot0[i] = f32x4{0.f, 0.f, 0.f, 0.f}; ot1[i] = ot0[i]; }
    float m0 = -1e30f, l0 = 0.f, m1 = -1e30f, l1 = 0.f;
    u32x4 k0, k1, k2, k3, v0, v1;
    const unsigned kvo = (unsigned)(((tid >> 5) * 256 + (tid & 31) * 8) * 2);
    const unsigned vvo = (unsigned)(((tid >> 3) * T + (tid & 7) * 8) * 2);
    LAS unsigned char* ksl = (LAS unsigned char*)smem + ((tid >> 5) * LDK + (tid & 31) * 8) * 2;
    LAS unsigned char* vsl = (LAS unsigned char*)smem + 33792 + ((tid >> 3) * LDV + (tid & 7) * 8) * 2;
#define D_LOAD(ktt)                                                                                    \
  do {                                                                                                 \
    const char* kb_ = (const char*)kg + (size_t)(ktt) * (64 * 256 * 2);                                \
    const char* vb_ = (const char*)vg + (size_t)(ktt) * 128;                                           \
    unsigned kvo_ = kvo, vvo_ = vvo;                                                                   \
    asm volatile("" : "+v"(kvo_), "+v"(vvo_));                                                         \
    k0 = *(const u32x4*)(kb_ + kvo_); k1 = *(const u32x4*)(kb_ + 8192 + kvo_);                         \
    k2 = *(const u32x4*)(kb_ + 16384 + kvo_); k3 = *(const u32x4*)(kb_ + 24576 + kvo_);                \
    v0 = *(const u32x4*)(vb_ + vvo_); v1 = *(const u32x4*)(vb_ + (size_t)64 * T * 2 + vvo_);           \
  } while (0)
    D_LOAD(0);
#pragma unroll 1
    for (int kt = 0; kt < nkt; ++kt) {
      __syncthreads();
      *(LAS u32x4*)(ksl) = k0; *(LAS u32x4*)(ksl + 16 * LDK * 2) = k1; *(LAS u32x4*)(ksl + 32 * LDK * 2) = k2; *(LAS u32x4*)(ksl + 48 * LDK * 2) = k3;
      *(LAS u32x4*)(vsl) = v0; *(LAS u32x4*)(vsl + 64 * LDV * 2) = v1;
      __syncthreads();
      f32x4 st0[4], st1[4];
#pragma unroll
      for (int m = 0; m < 4; ++m) {
        st0[m] = f32x4{0.f, 0.f, 0.f, 0.f};
        st1[m] = st0[m];
        const u16* krow = Ks + (16 * m + fr) * LDK;
#pragma unroll
        for (int s = 0; s < 8; ++s) {
          const uint2 x = *(const uint2*)(krow + 32 * s + fq * 4), y = *(const uint2*)(krow + 32 * s + 16 + fq * 4);
          U4 a;
          a.w[0] = x.x; a.w[1] = x.y; a.w[2] = y.x; a.w[3] = y.y;
          st0[m] = mfma16(a.h, qf0[s], st0[m]);
          st1[m] = mfma16(a.h, qf1[s], st1[m]);
        }
        if (m == 1) __builtin_amdgcn_sched_barrier(0);
      }
      U4 pb0[2], pb1[2];
      float alpha0, alpha1;
#define D_SOFTMAX(ST, MROW, QPOS, MR, LR, ALPHA, PB)                                                   \
  do {                                                                                                 \
    const u32x2 mm = *(const u32x2*)(mbase + (MROW) + (size_t)kt * 8 + mvo);                           \
    float mx = (MR);                                                                                   \
    _Pragma("unroll") for (int m = 0; m < 4; ++m) _Pragma("unroll") for (int r = 0; r < 4; ++r) {      \
      const int dist = (QPOS) - (kt * 64 + 16 * m + fq * 4 + r);                                       \
      const float sv = ST[m][r] + bias[dist < 0 ? 0 : dist];                                           \
      ST[m][r] = sv;                                                                                   \
      if (((m < 2 ? mm.x : mm.y) >> ((m & 1) * 16 + fq * 4 + r)) & 1u) mx = fmaxf(mx, sv);             \
    }                                                                                                  \
    mx = fmaxf(mx, __shfl_xor(mx, 16));                                                                \
    mx = fmaxf(mx, __shfl_xor(mx, 32));                                                                \
    ALPHA = __expf((MR) - mx);                                                                         \
    float ls = 0.f;                                                                                    \
    _Pragma("unroll") for (int m = 0; m < 4; ++m) _Pragma("unroll") for (int r = 0; r < 4; ++r) {      \
      const bool okb = (((m < 2 ? mm.x : mm.y) >> ((m & 1) * 16 + fq * 4 + r)) & 1u) != 0;             \
      const float pv = okb ? __expf(ST[m][r] - mx) : 0.f;                                              \
      ST[m][r] = pv;                                                                                   \
      ls += pv;                                                                                        \
    }                                                                                                  \
    LR = LR * ALPHA + ls;                                                                              \
    MR = mx;                                                                                           \
    _Pragma("unroll") for (int s = 0; s < 2; ++s) {                                                    \
      PB[s].w[0] = pack2(ST[2 * s][0], ST[2 * s][1]);                                                  \
      PB[s].w[1] = pack2(ST[2 * s][2], ST[2 * s][3]);                                                  \
      PB[s].w[2] = pack2(ST[2 * s + 1][0], ST[2 * s + 1][1]);                                          \
      PB[s].w[3] = pack2(ST[2 * s + 1][2], ST[2 * s + 1][3]);                                          \
    }                                                                                                  \
  } while (0)
      D_SOFTMAX(st0, 0, qpos0, m0, l0, alpha0, pb0);
      D_SOFTMAX(st1, 4096, qpos1, m1, l1, alpha1, pb1);
      if (kt + 1 < nkt) D_LOAD(kt + 1);
#pragma unroll
      for (int i = 0; i < 8; ++i) { ot0[i] *= alpha0; ot1[i] *= alpha1; }
#pragma unroll
      for (int s = 0; s < 2; ++s) {
#pragma unroll
        for (int mt = 0; mt < 8; ++mt) {
          const u16* vrow = Vt + (16 * mt + fr) * LDV + 32 * s;
          const uint2 x = *(const uint2*)(vrow + fq * 4), y = *(const uint2*)(vrow + 16 + fq * 4);
          U4 a;
          a.w[0] = x.x; a.w[1] = x.y; a.w[2] = y.x; a.w[3] = y.y;
          ot0[mt] = mfma16(a.h, pb0[s].h, ot0[mt]);
          ot1[mt] = mfma16(a.h, pb1[s].h, ot1[mt]);
          if ((mt & 1) == 1) __builtin_amdgcn_sched_barrier(0);
        }
      }
    }
    l0 += __shfl_xor(l0, 16); l0 += __shfl_xor(l0, 32);
    l1 += __shfl_xor(l1, 16); l1 += __shfl_xor(l1, 32);
    const float inv0 = 1.f / l0, inv1 = 1.f / l1;
    u16* d0 = (u16*)(ws + O_OLAT) + tq0 * 2048 + h * 256 + pass * 128;
    u16* d1 = d0 + 16 * 2048;
#pragma unroll
    for (int mt = 0; mt < 8; ++mt) {
      *(uint2*)(d0 + 16 * mt + fq * 4) = make_uint2(pack2(ot0[mt][0] * inv0, ot0[mt][1] * inv0), pack2(ot0[mt][2] * inv0, ot0[mt][3] * inv0));
      *(uint2*)(d1 + 16 * mt + fq * 4) = make_uint2(pack2(ot1[mt][0] * inv1, ot1[mt][1] * inv1), pack2(ot1[mt][2] * inv1, ot1[mt][3] * inv1));
    }
  }
}

__device__ __forceinline__ int snake_slot(int round, int G) { return (round & 1) ? (round * G + (G - 1 - opaque_s((int)blockIdx.x))) : (round * G + opaque_s((int)blockIdx.x)); }

__device__ __forceinline__ void idx_item(const P& p, int b, int qb16, char* smem) {
  char* ws = opaque_p(p.ws);
  const int tid = opaque(threadIdx.x), lane = tid & 63, wid = tid >> 6, fr = lane & 15, fq = lane >> 4;
  constexpr int LDQ = 1032;
  u16* Qh = (u16*)smem;
  u16* Ql = (u16*)(smem + 16 * LDQ * 2);
  float* wiS = (float*)(smem + 2 * 16 * LDQ * 2);
  const int q0 = qb16 * 16;
  const size_t t0 = (size_t)b * T + q0;
  float* sbuf = (float*)(ws + O_SCR) + (size_t)opaque_s((int)blockIdx.x) * 16 * 2048;
  __syncthreads();
#pragma unroll
  for (int i = 0; i < 4; ++i) {
    const int ci = tid + NTH * i, row = ci >> 7, c8 = ci & 127;
    *(uint4*)(Qh + row * LDQ + c8 * 8) = *(const uint4*)((const u16*)(ws + O_QIHI) + (t0 + row) * 1024 + c8 * 8);
    if (!NOSPLIT) *(uint4*)(Ql + row * LDQ + c8 * 8) = *(const uint4*)((const u16*)(ws + O_QILO) + (t0 + row) * 1024 + c8 * 8);
  }
  if (tid < 256) {
    const int q = tid & 15, hh = tid >> 4;
    wiS[hh * 16 + q] = ((const float*)(ws + O_WIDX))[(t0 + q) * 16 + hh] * 0.25f;
  }
  __syncthreads();
  const int nslab = (q0 + 16 + 63) >> 6;
  const int qpos = q0 + fr;
  for (int slab = wid; slab < nslab; slab += 8) {
    const int kb = slab * 64;
    bf16x8 kh[4][2], kl[4][2];
#pragma unroll
    for (int m = 0; m < 4; ++m)
#pragma unroll
      for (int s = 0; s < 2; ++s) {
        const size_t off = ((size_t)b * T + kb + 16 * m + fr) * 64 + 32 * s + fq * 8;
        U4 a, c;
        a.v = *(const uint4*)((const u16*)(ws + O_KIHI) + off);
        c.v = *(const uint4*)((const u16*)(ws + O_KILO) + off);
        kh[m][s] = a.h;
        kl[m][s] = c.h;
      }
    f32x4 sc[4];
#pragma unroll
    for (int m = 0; m < 4; ++m) sc[m] = f32x4{0.f, 0.f, 0.f, 0.f};
#pragma unroll 4
    for (int h = 0; h < 16; ++h) {
      U4 bh0, bh1, bl0, bl1;
      bh0.v = *(const uint4*)(Qh + fr * LDQ + h * 64 + fq * 8);
      bh1.v = *(const uint4*)(Qh + fr * LDQ + h * 64 + 32 + fq * 8);
      bl0.v = *(const uint4*)(Ql + fr * LDQ + h * 64 + fq * 8);
      bl1.v = *(const uint4*)(Ql + fr * LDQ + h * 64 + 32 + fq * 8);
      const float w = wiS[h * 16 + fr];
#pragma unroll
      for (int m = 0; m < 4; ++m) {
        f32x4 a = {0.f, 0.f, 0.f, 0.f};
        if (NOSPLIT == 0) {
          a = mfma16(kl[m][0], bh0.h, a);
          a = mfma16(kl[m][1], bh1.h, a);
          a = mfma16(kh[m][0], bl0.h, a);
          a = mfma16(kh[m][1], bl1.h, a);
        }
        a = mfma16(kh[m][0], bh0.h, a);
        a = mfma16(kh[m][1], bh1.h, a);
#pragma unroll
        for (int r = 0; r < 4; ++r) sc[m][r] += w * fmaxf(a[r], 0.f);
      }
    }
#pragma unroll
    for (int m = 0; m < 4; ++m) {
      const int key = kb + 16 * m + fq * 4;
      float4 o;
      o.x = (key + 0 <= qpos) ? sc[m][0] : -INFINITY;
      o.y = (key + 1 <= qpos) ? sc[m][1] : -INFINITY;
      o.z = (key + 2 <= qpos) ? sc[m][2] : -INFINITY;
      o.w = (key + 3 <= qpos) ? sc[m][3] : -INFINITY;
      *(float4*)(sbuf + fr * 2048 + key) = o;
    }
  }
  __syncthreads();
  {
    const int lane_q = opaque(lane);
    int ns_q = nslab;
    asm volatile("" : "+s"(ns_q));
    uint32_t uA[32], uB[32];
#define SEL_LOAD(U, QI)                                                                      \
  _Pragma("unroll") for (int j = 0; j < 32; ++j) {                                           \
    if (j < ns_q) {                                                                          \
      const uint32_t bits = __float_as_uint(sbuf[(QI) * 2048 + j * 64 + lane_q]);            \
      U[j] = (bits & 0x80000000u) ? ~bits : (bits | 0x80000000u);                            \
    } else U[j] = 0u;                                                                        \
  }
#define SEL_RUN(U, QI)                                                                       \
  do {                                                                                       \
    const int qp = q0 + (QI);                                                                \
    uint32_t* mdst = (uint32_t*)(ws + O_MASK) + (t0 + (QI)) * 64;                            \
    if (qp + 1 <= 256) {                                                                     \
      const int lo = 32 * lane_q;                                                            \
      uint32_t v;                                                                            \
      if (qp >= lo + 31) v = 0xffffffffu;                                                    \
      else if (qp < lo) v = 0u;                                                              \
      else v = (2u << (qp - lo)) - 1u;                                                       \
      mdst[lane_q] = v;                                                                      \
    } else {                                                                                 \
      uint32_t thr = 0;                                                                      \
      for (int bit = 31; bit >= 0; --bit) {                                                  \
        const uint32_t cand = thr | (1u << bit);                                             \
        int cnt = 0;                                                                         \
        _Pragma("unroll") for (int j = 0; j < 32; ++j) {                                     \
          cnt += __popcll(__ballot(U[j] >= cand));                                           \
          if ((j & 3) == 3) __builtin_amdgcn_sched_barrier(0);                               \
        }                                                                                    \
        if (cnt >= 256) thr = cand;                                                          \
        if (cnt == 256) break;                           \
      }                                                                                      \
      uint32_t mylo = 0, myhi = 0;                                                           \
      _Pragma("unroll") for (int j = 0; j < 32; ++j) {                                       \
        const unsigned long long bm = __ballot(U[j] >= thr);                                 \
        if (lane_q == j) { mylo = (uint32_t)bm; myhi = (uint32_t)(bm >> 32); }               \
        if ((j & 3) == 3) __builtin_amdgcn_sched_barrier(0);                                 \
      }                                                                                      \
      if (lane_q < 32) *(uint2*)(mdst + 2 * lane_q) = make_uint2(mylo, myhi);                \
    }                                                                                        \
  } while (0)
    SEL_LOAD(uA, wid)
    SEL_LOAD(uB, wid + 8)
    SEL_RUN(uA, wid);
    SEL_RUN(uB, wid + 8);
  }
}

__device__ __forceinline__ void phase_p4(const P& p, int l, char* smem) {
  char* ws = opaque_p(p.ws);
  const int G = gridDim.x;
  for (int round = 0;; ++round) {
    const int s = snake_slot(round, G);
    if (round * G >= 2048) break;
    if (s < 2048) idx_item(p, s & 15, 127 - (s >> 4), smem);
  }
  if (G == 256) {
    const int w = opaque_s((int)blockIdx.x), x = w & 7, j = w >> 3, psel = j >> 4, qbi = j & 15;
    for (int r = 0; r < 8; ++r) {
      const int pg = x * 16 + 2 * r + psel;
      attn_item<false>(p, pg >> 3, (r & 1) ? qbi : 15 - qbi, pg & 7, smem);
    }
  } else {
    for (int round = 0;; ++round) {
      const int s = snake_slot(round, G);
      if (round * G >= 2048) break;
      if (s < 2048) attn_item<false>(p, (s >> 3) & 15, 15 - (s >> 7), s & 7, smem);
    }
  }
  const float* d_skip = p.in(16) + l * 512;
  for (int it = opaque_s((int)blockIdx.x); it < 32 * 8 * 4; it += gridDim.x) {
    const int tn = it & 3, tm = (it >> 2) & 7, g = it >> 5;
    f32x4 acc[2][4];
    zero_acc(acc);
    {
      S5UAddr fa{(const u16*)(ws + O_U) + g * 16, tm * 128};
      S5ToepAddr fb{(const u16*)(ws + O_KTAB) + (size_t)g * 32 * 256, tn * 128};
      TileLd<S5UAddr> la(fa);
      TileLd<S5ToepAddr> lb(fb);
      gemm_loop(acc, la, lb, 8, smem);
    }
    {
      RowMajor fa{(const u16*)(ws + O_SPREV) + ((size_t)g * 1024 + tm * 128) * 128, 128};
      RowMajor fb{(const u16*)(ws + O_CM) + ((size_t)g * 512 + tn * 128) * 128, 128};
      TileLd<RowMajor> la(fa);
      TileLd<RowMajor> lb(fb);
      gemm_loop(acc, la, lb, 2, smem);
    }
    epi_each(acc, [&](int lr, int lc, f32x4 v) {
      const int col = tn * 128 + lc, i = col >> 4, po = col & 15, ch = g * 16 + po;
      const float dk = d_skip[ch];
#pragma unroll
      for (int r = 0; r < 4; ++r) {
        const int rc = tm * 128 + lr + r;
        const size_t t = (size_t)rc * 32 + i;
        const float uu = bf2f(((const u16*)(ws + O_U))[t * 512 + ch]);
        ((u16*)(ws + O_YACT))[t * 512 + ch] = f2bf(gelu_tanh(v[r] + dk * uu));
      }
    });
  }
}

__device__ __forceinline__ void phase_p5(const P& p, int l, char* smem) {
  char* ws = opaque_p(p.ws);
  const int G = gridDim.x;
  __syncthreads();
  {
    float* bias = (float*)(smem + 52224);
    const float* bsrc = (const float*)(ws + O_BIASD);
    for (int i = opaque(threadIdx.x); i < 8 * 2048; i += NTH) bias[i] = bsrc[i];
  }
  if (G == 256) {
    const int w = opaque_s((int)blockIdx.x), x = w & 7, j = w >> 3;
    for (int r = 0; r < 4; ++r) dsa_item(p, 2 * x + (r >> 1), (r & 1) ? j : 63 - j, smem);
  } else {
    for (int round = 0;; ++round) {
      const int s = snake_slot(round, G);
      if (round * G >= 1024) break;
      if (s < 1024) dsa_item(p, s & 15, 63 - (s >> 4), smem);
    }
  }
  const float* b_glu = p.in(18) + l * 512;
  for (int it = opaque_s((int)blockIdx.x); it < 128 * 2; it += gridDim.x) {
    const int tn = it & 1, tm = it >> 1;
    Acc256 acc;
    zero256(acc);
    gemm256(acc, (const u16*)(ws + O_YACT) + (size_t)tm * 256 * 512, 512, (const u16*)(ws + O_WGLU) + (size_t)tn * 256 * 512, 512, 512, smem);
    epi256(acc, [&](int lr, int lc, f32x4 v) {
      const int col = tn * 256 + lc;
      const float bg = b_glu[col];
#pragma unroll
      for (int r = 0; r < 4; ++r) {
        const size_t t = (size_t)tm * 256 + lr + r;
        const float y = bf2f(((const u16*)(ws + O_YACT))[t * 512 + col]);
        ((u16*)(ws + O_OB))[t * 512 + col] = f2bf(y * sigmoidf_(v[r] + bg));
      }
    });
  }
}


__device__ __forceinline__ void phase_oa(const P& p, char* smem) {
  char* ws = opaque_p(p.ws);
  for (int it = xcd_first_tile(); it < 128 * 2; it += gridDim.x) {
    const int tn = it & 1, tm = it >> 1;
    Acc256 acc;
    zero256(acc);
    gemm256(acc, (const u16*)(ws + O_OLAT) + (size_t)tm * 256 * 2048 + tn * 1024, 2048, (const u16*)(ws + O_WUVBD) + (size_t)tn * 256 * 2048 + tn * 1024, 2048, 1024, smem);
    epi256(acc, [&](int lr, int lc, f32x4 v) {
#pragma unroll
      for (int r = 0; r < 4; ++r) ((u16*)(ws + O_OA))[(size_t)(tm * 256 + lr + r) * 512 + tn * 256 + lc] = f2bf(v[r]);
    });
  }
}

__device__ __forceinline__ void phase_merge(const P& p, char* smem) {
  char* ws = opaque_p(p.ws);
  for (int it = xcd_first_tile(); it < 128 * 8; it += gridDim.x) {
    const int tn = it & 7, tm = it >> 3;
#define MRG_PTRS                                                                                                   \
  const int tid_ = opaque(threadIdx.x);                                                                            \
  uint4* gst = (uint4*)(opaque_p(p.ws) + O_GATE) + (size_t)opaque_s((int)blockIdx.x) * 16 * NTH + tid_;            \
  float4* mst = (float4*)(opaque_p(p.ws) + O_MRG) + (size_t)opaque_s((int)blockIdx.x) * 32 * NTH + tid_;
#pragma unroll 1
    for (int n = 0; n < 3; ++n) {
      {
        Acc256 acc;
        zero256(acc);
        gemm256(acc, (const u16*)(ws + O_XH) + (size_t)tm * 256 * DM, DM, (const u16*)(ws + O_WG) + ((size_t)n * DM + tn * 256) * DM, DM, DM, smem);
        MRG_PTRS
        (void)mst;
#pragma unroll
        for (int a = 0; a < 2; ++a)
#pragma unroll
          for (int b = 0; b < 2; ++b)
#pragma unroll
            for (int m = 0; m < 4; ++m) {
              const f32x4 v0 = acc[a][b][m][0], v1 = acc[a][b][m][1];
              *gst = make_uint4(pack2(sigmoidf_(v0[0]), sigmoidf_(v0[1])), pack2(sigmoidf_(v0[2]), sigmoidf_(v0[3])),
                                pack2(sigmoidf_(v1[0]), sigmoidf_(v1[1])), pack2(sigmoidf_(v1[2]), sigmoidf_(v1[3])));
              gst += NTH;
            }
      }
      {
        Acc256 acc;
        zero256(acc);
        const size_t ooff = (n == 0 ? O_OA : (n == 1 ? O_OB : O_OC));
        gemm256(acc, (const u16*)(ws + ooff) + (size_t)tm * 256 * 512, 512, (const u16*)(ws + O_WBR) + ((size_t)n * DM + tn * 256) * 512, 512, 512, smem);
        const float keep = (n > 0) ? 1.f : 0.f;
        MRG_PTRS
#pragma unroll
        for (int a = 0; a < 2; ++a)
#pragma unroll
          for (int b = 0; b < 2; ++b)
#pragma unroll
            for (int m = 0; m < 4; ++m) {
              const uint4 gg = *gst;
              gst += NTH;
#pragma unroll
              for (int c = 0; c < 2; ++c) {
                const f32x4 v = acc[a][b][m][c];
                const uint32_t g0 = c ? gg.z : gg.x, g1 = c ? gg.w : gg.y;
                float4 pm = make_float4(0.f, 0.f, 0.f, 0.f);
                if (n > 0) pm = *mst;
                pm.x = pm.x * keep + bf2f((u16)(g0 & 0xffff)) * v[0];
                pm.y = pm.y * keep + bf2f((u16)(g0 >> 16)) * v[1];
                pm.z = pm.z * keep + bf2f((u16)(g1 & 0xffff)) * v[2];
                pm.w = pm.w * keep + bf2f((u16)(g1 >> 16)) * v[3];
                *mst = pm;
                mst += NTH;
              }
              __builtin_amdgcn_sched_barrier(0);
            }
      }
    }
    {
      MRG_PTRS
      (void)gst;
      const int lane = tid_ & 63, wid = tid_ >> 6, wr = wid >> 2, wc = wid & 3, fr = lane & 15, fq = lane >> 4;
      u16* dbase = (u16*)(ws + O_MERGED) + (size_t)(tm * 256 + wr * 64 + fq * 4) * DM + tn * 256 + wc * 32 + fr;
#pragma unroll
      for (int a = 0; a < 2; ++a)
#pragma unroll
        for (int b = 0; b < 2; ++b)
#pragma unroll
          for (int m = 0; m < 4; ++m) {
#pragma unroll
            for (int c = 0; c < 2; ++c) {
              const float4 pm = *mst;
              mst += NTH;
              u16* d = dbase + (size_t)(a * 128 + m * 16) * DM + b * 128 + c * 16;
              d[0] = f2bf(pm.x); d[DM] = f2bf(pm.y); d[2 * DM] = f2bf(pm.z); d[3 * DM] = f2bf(pm.w);
            }
            __builtin_amdgcn_sched_barrier(0);
          }
    }
  }
}

__device__ __forceinline__ void phase_wout(const P& p, const float* x, char* smem) {
  char* ws = opaque_p(p.ws);
  float* z = (float*)(ws + O_X1);
  for (int it = xcd_first_tile(); it < 128 * 8; it += gridDim.x) {
    const int tn = it & 7, tm = it >> 3;
    Acc256 acc;
    zero256(acc);
    gemm256(acc, (const u16*)(ws + O_MERGED) + (size_t)tm * 256 * DM, DM, (const u16*)(ws + O_WOUT) + (size_t)tn * 256 * DM, DM, DM, smem);
    epi256(acc, [&](int lr, int lc, f32x4 v) {
#pragma unroll
      for (int r = 0; r < 4; ++r) {
        const size_t o = (size_t)(tm * 256 + lr + r) * DM + tn * 256 + lc;
        z[o] = ALPHA * x[o] + v[r];
      }
    });
  }
}

__device__ __forceinline__ void phase_ln(float* z, const float* g, const float* bta, u16* ohi, u16* olo) {
  const int lane = opaque(threadIdx.x) & 63, wid = opaque(threadIdx.x) >> 6;
  for (int it = opaque_s((int)blockIdx.x); it < NTOK / 8; it += gridDim.x) {
    const size_t rowi = (size_t)it * 8 + wid;
    float4* row = (float4*)(z + rowi * DM);
    float4 v[8];
    float s = 0.f;
#pragma unroll
    for (int i = 0; i < 8; ++i) { v[i] = row[lane + 64 * i]; s += v[i].x + v[i].y + v[i].z + v[i].w; }
    s = wave_sum(s);
    const float mu = s * (1.f / DM);
    float q = 0.f;
#pragma unroll
    for (int i = 0; i < 8; ++i) {
      v[i].x -= mu; v[i].y -= mu; v[i].z -= mu; v[i].w -= mu;
      q += v[i].x * v[i].x + v[i].y * v[i].y + v[i].z * v[i].z + v[i].w * v[i].w;
    }
    q = wave_sum(q);
    const float rs = rsqrtf(q * (1.f / DM) + 1e-5f);
#pragma unroll
    for (int i = 0; i < 8; ++i) {
      const float4 gg = ((const float4*)g)[lane + 64 * i], bb = ((const float4*)bta)[lane + 64 * i];
      float4 o;
      o.x = v[i].x * rs * gg.x + bb.x; o.y = v[i].y * rs * gg.y + bb.y;
      o.z = v[i].z * rs * gg.z + bb.z; o.w = v[i].w * rs * gg.w + bb.w;
      row[lane + 64 * i] = o;
      const u16 h0 = f2bf(o.x), h1 = f2bf(o.y), h2 = f2bf(o.z), h3 = f2bf(o.w);
      if (ohi) ((uint2*)(ohi + rowi * DM))[lane + 64 * i] = make_uint2((uint32_t)h0 | ((uint32_t)h1 << 16), (uint32_t)h2 | ((uint32_t)h3 << 16));
      if (olo) ((uint2*)(olo + rowi * DM))[lane + 64 * i] = make_uint2(pack2(o.x - bf2f(h0), o.y - bf2f(h1)), pack2(o.z - bf2f(h2), o.w - bf2f(h3)));
    }
  }
}

__device__ __forceinline__ void phase_up(const P& p, int l, char* smem) {
  char* ws = opaque_p(p.ws);
  const float* cw = p.in(24) + (size_t)l * 3 * 2 * DFF;
  const float* cb = p.in(25) + (size_t)l * 2 * DFF;
  u16* hA = (u16*)smem;
  u16* hV = (u16*)(smem + 65536);
  const int tid = opaque(threadIdx.x);
  for (int it = xcd_first_tile(); it < 33 * 176; it += gridDim.x) {
    const int mb = it / 176, rem = it - mb * 176, tn = rem >> 2, mt = mb * 4 + (rem & 3);
    if (mt >= 130) continue;
    const long tfirst = (long)mt * 254 - 2;
    Acc256 acc;
    zero256(acc);
    gemm256(acc, (const u16*)(ws + O_X1B) + tfirst * DM, DM, (const u16*)(ws + O_WUP) + (size_t)tn * 256 * DM, DM, DM, smem);
    __syncthreads();
    {
      const int lane = tid & 63, wid = tid >> 6, wr = wid >> 2, wc = wid & 3, fr = lane & 15, fq = lane >> 4;
      LAS u16* bA = (LAS u16*)(LAS unsigned char*)smem + opaque((wr * 64 + fq * 4) * 128 + wc * 32 + fr);
#pragma unroll
      for (int a = 0; a < 2; ++a)
#pragma unroll
        for (int m = 0; m < 4; ++m) {
#pragma unroll
          for (int c = 0; c < 2; ++c) {
#pragma unroll
            for (int r = 0; r < 4; ++r) {
              bA[(a * 128 + m * 16 + r) * 128 + c * 16] = f2bf(acc[a][0][m][c][r]);
              bA[32768 + (a * 128 + m * 16 + r) * 128 + c * 16] = f2bf(acc[a][1][m][c][r]);
            }
          }
          __builtin_amdgcn_sched_barrier(0);
        }
    }
    __syncthreads();
    {
      typedef __attribute__((ext_vector_type(2))) float f2;
      const int c = (tid & 63) * 2, rg = tid >> 6;
      const int ca = tn * 128 + c, cv = DFF + ca;
      const f2 wa0 = *(const f2*)(cw + ca), wa1 = *(const f2*)(cw + 2 * DFF + ca), wa2 = *(const f2*)(cw + 4 * DFF + ca), ba = *(const f2*)(cb + ca);
      const f2 wv0 = *(const f2*)(cw + cv), wv1 = *(const f2*)(cw + 2 * DFF + cv), wv2 = *(const f2*)(cw + 4 * DFF + cv), bv = *(const f2*)(cb + cv);
      const int i0 = (rg == 0) ? 2 : rg * 32, i1 = rg * 32 + 32;
      auto ld2 = [&](const u16* base, int row) -> f2 {
        const uint32_t w = *(const uint32_t*)(base + row * 128 + c);
        f2 r;
        r.x = __uint_as_float(w << 16);
        r.y = __uint_as_float(w & 0xffff0000u);
        return r;
      };
      f2 a2 = ld2(hA, i0 - 2), a1 = ld2(hA, i0 - 1), v2 = ld2(hV, i0 - 2), v1 = ld2(hV, i0 - 1);
      u16* dst = (u16*)(ws + O_ACT) + ca;
      for (int i = i0; i < i1; ++i) {
        const f2 a0 = ld2(hA, i), v0 = ld2(hV, i);
        const long t = tfirst + i;
        if (t < NTOK) {
          const int tt = (int)(t & 2047);
          const float k2 = (tt >= 2) ? 1.f : 0.f, k1 = (tt >= 1) ? 1.f : 0.f;
          const f2 ha = ba + (wa0 * a2) * k2 + (wa1 * a1) * k1 + wa2 * a0;
          const f2 hv = bv + (wv0 * v2) * k2 + (wv1 * v1) * k1 + wv2 * v0;
          const f2 u = (ha + ha * ha * ha * 0.044715f) * (2.f * 0.7978845608028654f);
          f2 gl;
          gl.x = ha.x / (1.f + __expf(-u.x));
          gl.y = ha.y / (1.f + __expf(-u.y));
          const f2 o = gl * hv;
          *(uint32_t*)(dst + (size_t)t * DFF) = pack2(o.x, o.y);
        }
        a2 = a1; a1 = a0; v2 = v1; v1 = v0;
      }
    }
  }
}

__device__ __forceinline__ void phase_down(const P& p, char* smem) {
  char* ws = opaque_p(p.ws);
  const float* x1 = (const float*)(ws + O_X1);
  float* z = p.out;
  for (int it = xcd_first_tile(); it < 128 * 8; it += gridDim.x) {
    const int tn = it & 7, tm = it >> 3;
    Acc256 acc;
    zero256(acc);
    gemm256(acc, (const u16*)(ws + O_ACT) + (size_t)tm * 256 * DFF, DFF, (const u16*)(ws + O_WDOWN) + (size_t)tn * 256 * DFF, DFF, DFF, smem);
    epi256(acc, [&](int lr, int lc, f32x4 v) {
#pragma unroll
      for (int r = 0; r < 4; ++r) {
        const size_t o = (size_t)(tm * 256 + lr + r) * DM + tn * 256 + lc;
        z[o] = ALPHA * x1[o] + v[r];
      }
    });
  }
}


constexpr size_t O_BAR = 1020 * MiB;
#define XB_TMO 128
#define XB_XCNT(j) (256 + 64 * (j))
#define XB_XSUB(j) (1280 + 64 * (j))
#define XB_XGEN(j) (2304 + 64 * (j))
#define XB_TOP 3328
#define XB_TOPGEN 3392
#define XCD_BAR_WORDS 3456
#define XB_SPIN_CAP (1u << 22)
__device__ __forceinline__ unsigned xb_ld(unsigned* p) { return __hip_atomic_load(p, __ATOMIC_RELAXED, __HIP_MEMORY_SCOPE_AGENT); }
__device__ __forceinline__ unsigned xb_add(unsigned* p, unsigned v) { return __hip_atomic_fetch_add(p, v, __ATOMIC_RELAXED, __HIP_MEMORY_SCOPE_AGENT); }
__device__ __forceinline__ unsigned xb_xcc_id() { return (unsigned)__builtin_amdgcn_s_getreg((3 << 11) | 20) & 0xFu; }
#define XB_SPIN(cond, bar)                                                               \
  do {                                                                                   \
    unsigned _sp = 0;                                                                    \
    while (cond) {                                                                       \
      __builtin_amdgcn_s_sleep(1);                                                       \
      if ((++_sp & 255u) == 0u) {                                                        \
        if (xb_ld(&(bar)[XB_TMO])) break;                                                \
        if (_sp > XB_SPIN_CAP) { atomicAdd(&(bar)[XB_TMO], 1u); break; }                 \
      }                                                                                  \
    }                                                                                    \
  } while (0)
__device__ __forceinline__ void xcd_barrier_complete(unsigned* bar, unsigned x, unsigned& nloc, unsigned& nx) {
  const unsigned G = gridDim.x;
  unsigned sum, cnt, mine, sp = 0u;
  for (;;) {
    sum = 0u; cnt = 0u; mine = 0u;
#pragma unroll
    for (unsigned j = 0; j < 16; ++j) {
      const unsigned c = xb_ld(&bar[XB_XCNT(j)]);
      sum += c;
      cnt += (c > 0u) ? 1u : 0u;
      mine = (j == x) ? c : mine;
    }
    if (sum == G) break;
    __builtin_amdgcn_s_sleep(1);
    if ((++sp & 255u) == 0u) {
      if (xb_ld(&bar[XB_TMO])) break;
      if (sp > XB_SPIN_CAP) { atomicAdd(&bar[XB_TMO], 1u); break; }
    }
  }
  nloc = mine > 0u ? mine : 1u;
  nx = cnt > 0u ? cnt : 1u;
}
__device__ __forceinline__ void xcd_barrier(char* ws_, volatile LAS unsigned* st) {
  asm volatile("s_waitcnt vmcnt(0)" ::: "memory");
  __syncthreads();
  if (threadIdx.x == 0) {
    unsigned* bar = (unsigned*)(opaque_p(ws_) + O_BAR);
    const unsigned x = xb_xcc_id();
    __builtin_amdgcn_s_waitcnt(0);
    unsigned nloc = st[0], nx = st[1];
    if (nloc == 0u) {
      xcd_barrier_complete(bar, x, nloc, nx);
      st[0] = nloc;
      st[1] = nx;
    }
    const unsigned old = xb_add(&bar[XB_XSUB(x)], 1u);
    const unsigned gen = old / nloc;
    if (old + 1u == (gen + 1u) * nloc) {
      __builtin_amdgcn_fence(__ATOMIC_RELEASE, "agent");
      asm volatile("s_waitcnt vmcnt(0)" ::: "memory");
      const unsigned og = xb_add(&bar[XB_TOP], 1u);
      const unsigned tg = og / nx;
      if (og + 1u == (tg + 1u) * nx) xb_add(&bar[XB_TOPGEN], 1u);
      else XB_SPIN(xb_ld(&bar[XB_TOPGEN]) == tg, bar);
      __builtin_amdgcn_fence(__ATOMIC_ACQUIRE, "agent");
      xb_add(&bar[XB_XGEN(x)], 1u);
      asm volatile("s_waitcnt vmcnt(0)" ::: "memory");
    } else {
      XB_SPIN(xb_ld(&bar[XB_XGEN(x)]) == gen, bar);
      __builtin_amdgcn_fence(__ATOMIC_ACQUIRE, "agent");
      asm volatile("s_waitcnt vmcnt(0)" ::: "memory");
    }
  }
  __syncthreads();
}

__global__ void __launch_bounds__(512, 2) mega(PK pk) {
  extern __shared__ __attribute__((aligned(16))) char smem[];
  cg::grid_group grid = cg::this_grid();
  {
    LAS unsigned long long* tabw = (LAS unsigned long long*)(LAS unsigned char*)(smem + 131072);
    if (opaque(threadIdx.x) == 0) {
#pragma unroll
      for (int i = 0; i < 29; ++i) tabw[i] = (unsigned long long)pk.in[i];
    }
    volatile LAS unsigned* stw = (volatile LAS unsigned*)(LAS unsigned char*)(smem + 131072 + 240);
    if (threadIdx.x == 0) { stw[0] = 0u; stw[1] = 0u; }
    __syncthreads();
    if (threadIdx.x == 0) (void)xb_add((unsigned*)(pk.ws + O_BAR) + XB_XCNT(xb_xcc_id()), 1u);
  }
  volatile LAS unsigned* xst = (volatile LAS unsigned*)(LAS unsigned char*)(smem + 131072 + 240);
  P p;
  p.tab = (const LAS unsigned long long*)(LAS unsigned char*)(smem + 131072);
  p.out = pk.out;
  p.ws = pk.ws;
#pragma unroll
  for (int l = 0; l < 2; ++l) {
    const float* x = (l == 0) ? p.in(0) : p.out;
    phase_prep(p, l, smem);
    if (l == 0) grid.sync(); else xcd_barrier(p.ws, xst);
    phase_gemm_in(p, smem);
    xcd_barrier(p.ws, xst);
    phase_p2(p, l, smem);
    xcd_barrier(p.ws, xst);
    phase_p3(p, smem);
    xcd_barrier(p.ws, xst);
    phase_p4(p, l, smem);
    xcd_barrier(p.ws, xst);
    phase_p5(p, l, smem);
    xcd_barrier(p.ws, xst);
    phase_oa(p, smem);
    xcd_barrier(p.ws, xst);
    phase_merge(p, smem);
    xcd_barrier(p.ws, xst);
    phase_wout(p, x, smem);
    xcd_barrier(p.ws, xst);
    phase_ln((float*)(p.ws + O_X1), p.in(21) + l * DM, p.in(22) + l * DM, (u16*)(p.ws + O_X1B), nullptr);
    xcd_barrier(p.ws, xst);
    phase_up(p, l, smem);
    xcd_barrier(p.ws, xst);
    phase_down(p, smem);
    xcd_barrier(p.ws, xst);
    phase_ln(p.out, p.in(27) + l * DM, p.in(28) + l * DM, l == 0 ? (u16*)(p.ws + O_XH) : nullptr, (l == 0 && !NOSPLIT) ? (u16*)(p.ws + O_XL) : nullptr);
  }
}

extern "C" void kernel_launch(void* const* d_in, const int* in_sizes, int n_in, void* d_out, int out_size, void* d_ws, size_t ws_size,
                              hipStream_t stream) {
  static int grid_blocks = 0;
  if (!grid_blocks) {
    int dev = 0, cus = 0;
    (void)hipGetDevice(&dev);
    (void)hipDeviceGetAttribute(&cus, hipDeviceAttributeMultiprocessorCount, dev);
    (void)hipFuncSetAttribute((const void*)mega, hipFuncAttributeMaxDynamicSharedMemorySize, SMEM_BYTES);
    grid_blocks = cus;
    if (ws_size < 1020 * MiB) fprintf(stderr, "kernel_launch: workspace too small: %zu\n", ws_size);
  }
  PK p{};
  for (int i = 0; i < 29; ++i) p.in[i] = (const float*)d_in[i];
  p.out = (float*)d_out;
  p.ws = (char*)d_ws;
  (void)hipMemsetAsync((char*)d_ws + O_BAR, 0, XCD_BAR_WORDS * 4, stream);
  void* args[] = {&p};
  hipError_t e = hipLaunchCooperativeKernel((const void*)mega, dim3(grid_blocks), dim3(NTH), args, SMEM_BYTES, stream);
  if (e != hipSuccess) fprintf(stderr, "cooperative launch failed: %s (grid %d)\n", hipGetErrorString(e), grid_blocks);
}
```

```cpp
#include <hip/hip_runtime.h>
#include <hip/hip_cooperative_groups.h>
#include <cstdio>
#include <cstdint>
namespace cg = cooperative_groups;

typedef unsigned short u16;
typedef __attribute__((ext_vector_type(8))) short bf16x8;
typedef __attribute__((ext_vector_type(4))) float f32x4;
typedef __attribute__((ext_vector_type(4))) unsigned int u32x4;
typedef __attribute__((ext_vector_type(2))) unsigned int u32x2;

constexpr int T = 2048, NB = 16, NTOK = NB * T, DM = 2048;
constexpr int INW = 8912, NA = 2768, NAP = 2816;
constexpr int DFF = 5632;
constexpr float ALPHA = 1.41421356237f;
constexpr int SMEM_BYTES = 131072 + 256;
constexpr int NTH = 512;

constexpr size_t MiB = 1048576;
constexpr size_t O_WINHI = 0, O_WINLO = 11 * MiB, O_WG = 22 * MiB, O_WQHI = 46 * MiB, O_WQLO = 47 * MiB + 512 * 1024,
                 O_WUK = 49 * MiB, O_WUVP = 49 * MiB + 512 * 1024, O_WGLU = 50 * MiB, O_WBR = 51 * MiB, O_WOUT = 57 * MiB,
                 O_WUP = 65 * MiB, O_WDOWN = 109 * MiB, O_KTAB = 131 * MiB, O_CM = 132 * MiB, O_BM = 136 * MiB,
                 O_LAML = 140 * MiB, O_BIASD = 140 * MiB + 512 * 1024;
constexpr size_t O_X1 = 144 * MiB;
constexpr size_t O_XL = 144 * MiB, O_XH = 272 * MiB;
constexpr size_t O_QIHI = 144 * MiB, O_QILO = 208 * MiB, O_SCR = 972 * MiB, O_SLOC = 1004 * MiB, O_SPREV = 400 * MiB;
constexpr size_t O_MRG = 144 * MiB, O_GATE = 208 * MiB, O_X1B = 752 * MiB;
constexpr size_t O_CQ = 400 * MiB, O_CKV = 448 * MiB, O_KIDX = 480 * MiB, O_WIDX = 488 * MiB, O_U = 490 * MiB, O_QC = 522 * MiB,
                 O_KC = 586 * MiB, O_KCB = 650 * MiB, O_VT = 682 * MiB, O_CQNHI = 714 * MiB, O_CQNLO = 738 * MiB,
                 O_CKVN = 762 * MiB, O_CKVNT = 778 * MiB, O_KIHI = 794 * MiB, O_KILO = 798 * MiB, O_KMEAN = 802 * MiB,
                 O_MSEL = 803 * MiB, O_Q = 804 * MiB, O_MASK = 836 * MiB, O_YACT = 844 * MiB, O_OA = 876 * MiB, O_OB = 908 * MiB,
                 O_OC = 940 * MiB;
constexpr size_t O_MERGED = 400 * MiB, O_ACT = 400 * MiB;
constexpr size_t O_WUVBD = 141 * MiB, O_OLAT = 144 * MiB;

#define NOSPLIT 1
struct PK {
  const float* in[29];
  float* out;
  char* ws;
};
#define LAS __attribute__((address_space(3)))
struct P {
  const LAS unsigned long long* tab;
  float* out;
  char* ws;
  __device__ __forceinline__ const float* in(int i) const {
    unsigned addr = (unsigned)(size_t)tab;
    asm volatile("" : "+s"(addr));
    const unsigned long long v = *(const LAS unsigned long long*)(size_t)(addr + 8u * (unsigned)i);
    const unsigned lo = __builtin_amdgcn_readfirstlane((unsigned)v), hi = __builtin_amdgcn_readfirstlane((unsigned)(v >> 32));
    return (const float*)(__attribute__((address_space(1))) const float*)(((unsigned long long)hi << 32) | (unsigned long long)lo);
  }
};

__device__ __forceinline__ u16 f2bf(float f) {
  uint32_t u = __float_as_uint(f);
  u += 0x7fffu + ((u >> 16) & 1u);
  return (u16)(u >> 16);
}
__device__ __forceinline__ float bf2f(u16 h) { return __uint_as_float(((uint32_t)h) << 16); }
__device__ __forceinline__ uint32_t pack2(float a, float b) { return (uint32_t)f2bf(a) | ((uint32_t)f2bf(b) << 16); }
__device__ __forceinline__ float sigmoidf_(float x) { return 1.f / (1.f + __expf(-x)); }
__device__ __forceinline__ float gelu_tanh(float x) {
  float u = 0.7978845608028654f * (x + 0.044715f * x * x * x);
  return x * sigmoidf_(2.f * u);
}
__device__ __forceinline__ float wave_sum(float v) {
#pragma unroll
  for (int o = 32; o >= 1; o >>= 1) v += __shfl_xor(v, o);
  return v;
}
__device__ __forceinline__ f32x4 mfma16(bf16x8 a, bf16x8 b, f32x4 c) {
  return __builtin_amdgcn_mfma_f32_16x16x32_bf16(a, b, c, 0, 0, 0);
}
__device__ __forceinline__ int opaque(int x) {
  asm volatile("" : "+v"(x));
  return x;
}
__device__ __forceinline__ int opaque_s(int x) {
  asm volatile("" : "+s"(x));
  return x;
}
template <class Tp>
__device__ __forceinline__ Tp* opaque_p(Tp* q) {
  __attribute__((address_space(1))) Tp* g = (__attribute__((address_space(1))) Tp*)q;
  asm volatile("" : "+s"(g));
  return (Tp*)g;
}
union U4 {
  uint4 v;
  bf16x8 h;
  uint32_t w[4];
  u16 s[8];
};

constexpr int G_BK = 64, G_HALF = 128, G_HT = G_HALF * G_BK;
__device__ __forceinline__ int lds_byte(int r, int c) {
  int st = (r >> 4) * 2 + (c >> 5), rr = r & 15, cc = c & 31, ob = rr * 64 + cc * 2;
  return st * 1024 + (ob ^ (((ob >> 9) & 1) << 5));
}
__device__ __forceinline__ void stage_rc(int b, int& R, int& C) {
  int st = b / 1024, sb = b % 1024, swz = sb ^ (((sb >> 9) & 1) << 5);
  R = (st >> 1) * 16 + swz / 64;
  C = (st & 1) * 32 + (swz % 64) / 2;
}
typedef f32x4 Acc256[2][2][4][2];
__device__ __forceinline__ void zero256(Acc256& acc) {
#pragma unroll
  for (int a = 0; a < 2; ++a)
#pragma unroll
    for (int b = 0; b < 2; ++b)
#pragma unroll
      for (int m = 0; m < 4; ++m)
#pragma unroll
        for (int n = 0; n < 2; ++n) acc[a][b][m][n] = f32x4{0.f, 0.f, 0.f, 0.f};
}
__device__ __forceinline__ void gemm256(Acc256& acc, const u16* A, int lda, const u16* Bt, int ldb, int K, char* shmc) {
  LAS unsigned char* lds = (LAS unsigned char*)shmc;
  constexpr int HTB = G_HT * 2;
  const int tid = opaque(threadIdx.x), wid = __builtin_amdgcn_readfirstlane(tid >> 6), lane = tid & 63, wr = wid >> 2, wc = wid & 3, fr = lane & 15, fq = lane >> 4;
  const int nt = K / G_BK;
  unsigned voffA[2], voffB[2];
#pragma unroll
  for (int i = 0; i < 2; ++i) {
    int R, C;
    stage_rc(tid * 16 + i * 8192, R, C);
    voffA[i] = (unsigned)(R * lda + C) * 2u;
    voffB[i] = (unsigned)(R * ldb + C) * 2u;
  }
  const size_t kstep = (size_t)(G_BK * 2);
  const size_t hA = (size_t)G_HALF * lda * 2, hB = (size_t)G_HALF * ldb * 2;
  const unsigned ldsw = (unsigned)wid * 1024u;
  const int aoff = lds_byte(wr * 64 + fr, fq * 8), boff = lds_byte(wc * 32 + fr, fq * 8);
  const char* cA = (const char*)A;
  const char* cB = (const char*)Bt;
#define G_SA(b, h) (((b) * 2 + (h)) * HTB)
#define G_SB(b, h) ((4 + (b) * 2 + (h)) * HTB)
#define G_STAGE(bufoff, gbase, voff)                                                                                   \
  do {                                                                                                                 \
    _Pragma("unroll") for (int _i = 0; _i < 2; ++_i)                                                                   \
        __builtin_amdgcn_global_load_lds((const unsigned*)((const char*)(gbase) + (voff)[_i]),                         \
                                         (LAS unsigned*)(lds + (bufoff) + ldsw + _i * 8192), 16, 0, 0);                \
  } while (0)
#define G_LDA(dst, b, h)                                                                                               \
  do {                                                                                                                 \
    _Pragma("unroll") for (int m = 0; m < 4; ++m) _Pragma("unroll") for (int k = 0; k < 2; ++k)                        \
        dst[m][k] = *(const LAS bf16x8*)(lds + G_SA(b, h) + aoff + m * 2048 + k * 1024);                               \
  } while (0)
#define G_LDB(dst, b, h)                                                                                               \
  do {                                                                                                                 \
    _Pragma("unroll") for (int n = 0; n < 2; ++n) _Pragma("unroll") for (int k = 0; k < 2; ++k)                        \
        dst[n][k] = *(const LAS bf16x8*)(lds + G_SB(b, h) + boff + n * 2048 + k * 1024);                               \
  } while (0)
#define G_MMA(ai, bj, At_, Bt_)                                                                                        \
  do {                                                                                                                 \
    __builtin_amdgcn_s_setprio(1);                                                                                     \
    _Pragma("unroll") for (int m = 0; m < 4; ++m) _Pragma("unroll") for (int n = 0; n < 2; ++n)                        \
        _Pragma("unroll") for (int k = 0; k < 2; ++k) acc[ai][bj][m][n] =                                              \
            __builtin_amdgcn_mfma_f32_16x16x32_bf16(At_[m][k], Bt_[n][k], acc[ai][bj][m][n], 0, 0, 0);                 \
    __builtin_amdgcn_s_setprio(0);                                                                                     \
  } while (0)
#define WAIT_V(n) asm volatile("s_waitcnt vmcnt(" #n ")" ::: "memory")
#define WAIT_L(n) asm volatile("s_waitcnt lgkmcnt(" #n ")" ::: "memory")
#define BAR __builtin_amdgcn_s_barrier()
#define SCHED __builtin_amdgcn_sched_barrier(0)
  bf16x8 At[4][2], B0[2][2], B1[2][2];
  asm volatile("s_waitcnt vmcnt(0) lgkmcnt(0)" ::: "memory");
  __syncthreads();
  G_STAGE(G_SB(0, 0), cB, voffB); G_STAGE(G_SA(0, 0), cA, voffA); G_STAGE(G_SB(0, 1), cB + hB, voffB); G_STAGE(G_SA(0, 1), cA + hA, voffA);
  if (wr == 1) BAR;
  WAIT_V(4); BAR;
  G_STAGE(G_SB(1, 0), cB + kstep, voffB); G_STAGE(G_SA(1, 0), cA + kstep, voffA); G_STAGE(G_SB(1, 1), cB + hB + kstep, voffB);
  WAIT_V(6); BAR;
  for (int t = 0; t < nt - 2; t += 2) {
    const char* a1 = cA + (size_t)(t + 1) * kstep;
    const char* a2 = cA + (size_t)(t + 2) * kstep;
    const char* b2 = cB + (size_t)(t + 2) * kstep;
    const char* a3 = a2 + kstep;
    const char* b3 = b2 + kstep;
    G_LDB(B0, 0, 0); SCHED; G_LDA(At, 0, 0); G_STAGE(G_SA(1, 1), a1 + hA, voffA);
    WAIT_L(8); BAR; WAIT_L(0); G_MMA(0, 0, At, B0); BAR; SCHED;
    G_LDB(B1, 0, 1); G_STAGE(G_SB(0, 0), b2, voffB);
    BAR; WAIT_L(0); G_MMA(0, 1, At, B1); BAR;
    G_LDA(At, 0, 1); G_STAGE(G_SA(0, 0), a2, voffA);
    BAR; WAIT_L(0); G_MMA(1, 0, At, B0); BAR; SCHED;
    G_STAGE(G_SB(0, 1), b2 + hB, voffB);
    WAIT_V(6); BAR; G_MMA(1, 1, At, B1); BAR;
    G_LDB(B0, 1, 0); SCHED; G_LDA(At, 1, 0); G_STAGE(G_SA(0, 1), a2 + hA, voffA);
    WAIT_L(8); BAR; WAIT_L(0); G_MMA(0, 0, At, B0); BAR; SCHED;
    G_LDB(B1, 1, 1); G_STAGE(G_SB(1, 0), b3, voffB);
    BAR; WAIT_L(0); G_MMA(0, 1, At, B1); BAR;
    G_LDA(At, 1, 1); G_STAGE(G_SA(1, 0), a3, voffA);
    BAR; WAIT_L(0); G_MMA(1, 0, At, B0); BAR; SCHED;
    G_STAGE(G_SB(1, 1), b3 + hB, voffB);
    WAIT_V(6); BAR; G_MMA(1, 1, At, B1); BAR;
  }
  {
    const char* a1 = cA + (size_t)(nt - 1) * kstep;
    G_LDB(B0, 0, 0); G_LDA(At, 0, 0); G_STAGE(G_SA(1, 1), a1 + hA, voffA);
    BAR; WAIT_L(0); G_MMA(0, 0, At, B0); BAR;
    G_LDB(B1, 0, 1); BAR; WAIT_L(0); G_MMA(0, 1, At, B1); BAR;
    G_LDA(At, 0, 1); WAIT_V(4); BAR; WAIT_L(0); G_MMA(1, 0, At, B0); G_MMA(1, 1, At, B1); BAR;
  }
  {
    G_LDB(B0, 1, 0); G_LDA(At, 1, 0); WAIT_V(2); BAR; WAIT_L(0); G_MMA(0, 0, At, B0); BAR;
    G_LDB(B1, 1, 1); WAIT_V(0); BAR; WAIT_L(0); G_MMA(0, 1, At, B1); BAR;
    G_LDA(At, 1, 1); BAR; WAIT_L(0); G_MMA(1, 0, At, B0); G_MMA(1, 1, At, B1); BAR;
  }
  if (wr == 0) BAR;
}
__device__ __forceinline__ int xcd_first_tile() {
  const int bx = opaque_s((int)blockIdx.x), G = (int)gridDim.x;
  return (G & 7) ? bx : (bx & 7) * (G >> 3) + (bx >> 3);
}
template <class F>
__device__ __forceinline__ void epi256(Acc256& acc, F f) {
  const int tidx = opaque(threadIdx.x);
  const int wid = tidx >> 6, lane = tidx & 63, wr = wid >> 2, wc = wid & 3, fr = lane & 15, fq = lane >> 4;
#pragma unroll
  for (int ai = 0; ai < 2; ++ai)
#pragma unroll
    for (int bj = 0; bj < 2; ++bj)
#pragma unroll
      for (int m = 0; m < 4; ++m)
#pragma unroll
        for (int n = 0; n < 2; ++n) f(ai * 128 + wr * 64 + m * 16 + fq * 4, bj * 128 + wc * 32 + n * 16 + fr, acc[ai][bj][m][n]);
}

template <class AF>
struct TileLd {
  static constexpr int BK = 64, CPR = 8, NCH = 2, LDR = BK + 8;
  AF f;
  int t;
  uint4 r[NCH];
  __device__ __forceinline__ TileLd(AF f_) : f(f_), t(opaque(threadIdx.x)) {}
  __device__ __forceinline__ void load(int kt) {
#pragma unroll
    for (int i = 0; i < NCH; ++i) {
      const int ci = t + NTH * i, row = ci / CPR, c8 = ci % CPR;
      const u16* p = (const u16*)f(row, kt, c8);
      r[i] = p ? *(const uint4*)p : make_uint4(0, 0, 0, 0);
    }
  }
  __device__ __forceinline__ void store(char* dst) {
#pragma unroll
    for (int i = 0; i < NCH; ++i) {
      const int ci = t + NTH * i, row = ci / CPR, c8 = ci % CPR;
      *(uint4*)(dst + (row * LDR + c8 * 8) * 2) = r[i];
    }
  }
};
template <class LA, class LB>
__device__ __forceinline__ void gemm_loop(f32x4 (&acc)[2][4], LA& la, LB& lb, int nk, char* smem) {
  constexpr int BK = 64, LDR = BK + 8, TILE = 128 * LDR * 2, STAGE = 2 * TILE;
  const int tid = opaque(threadIdx.x), lane = tid & 63, wid = tid >> 6, wr = wid >> 1, wc = wid & 1, fr = lane & 15, fq = lane >> 4;
  la.load(0);
  lb.load(0);
  __syncthreads();
  la.store(smem);
  lb.store(smem + TILE);
  __syncthreads();
  for (int kt = 0; kt < nk; ++kt) {
    char* st = smem + (kt & 1) * STAGE;
    if (kt + 1 < nk) {
      la.load(kt + 1);
      lb.load(kt + 1);
    }
#pragma unroll
    for (int ks = 0; ks < 2; ++ks) {
      bf16x8 a[2], b[4];
#pragma unroll
      for (int m = 0; m < 2; ++m) a[m] = *(const bf16x8*)(st + ((wr * 32 + m * 16 + fr) * LDR + ks * 32 + fq * 8) * 2);
#pragma unroll
      for (int n = 0; n < 4; ++n) b[n] = *(const bf16x8*)(st + TILE + ((wc * 64 + n * 16 + fr) * LDR + ks * 32 + fq * 8) * 2);
#pragma unroll
      for (int m = 0; m < 2; ++m)
#pragma unroll
        for (int n = 0; n < 4; ++n) acc[m][n] = mfma16(a[m], b[n], acc[m][n]);
    }
    if (kt + 1 < nk) {
      char* sn = smem + ((kt + 1) & 1) * STAGE;
      la.store(sn);
      lb.store(sn + TILE);
    }
    __syncthreads();
  }
}
__device__ __forceinline__ void zero_acc(f32x4 (&acc)[2][4]) {
#pragma unroll
  for (int m = 0; m < 2; ++m)
#pragma unroll
    for (int n = 0; n < 4; ++n) acc[m][n] = f32x4{0.f, 0.f, 0.f, 0.f};
}
template <class F>
__device__ __forceinline__ void epi_each(f32x4 (&acc)[2][4], F f) {
  const int tid_ = opaque(threadIdx.x);
  const int lane = tid_ & 63, wid = tid_ >> 6, wr = wid >> 1, wc = wid & 1, fr = lane & 15, fq = lane >> 4;
#pragma unroll
  for (int m = 0; m < 2; ++m)
#pragma unroll
    for (int n = 0; n < 4; ++n) f(wr * 32 + m * 16 + fq * 4, wc * 64 + n * 16 + fr, acc[m][n]);
}
struct RowMajor {
  const u16* base;
  size_t ld;
  __device__ __forceinline__ const void* operator()(int row, int kt, int c8) const { return base + (size_t)row * ld + (size_t)kt * 64 + c8 * 8; }
};

template <class RM>
__device__ __forceinline__ void tr_tile(const float* src, int ldsrc, int C, u16* dhi, u16* dlo, int ldd, RM rm, int tr, int tc, float* sm) {
  const int t = opaque(threadIdx.x);
  const int r0 = tr * 64, c0 = tc * 64;
  __syncthreads();
  {
    const int c = t & 63;
#pragma unroll
    for (int i = 0; i < 8; ++i) {
      const int r = (t >> 6) + 8 * i;
      sm[r * 65 + c] = (c0 + c < C) ? src[(size_t)(r0 + r) * ldsrc + c0 + c] : 0.f;
    }
  }
  __syncthreads();
  {
    const int r = t & 63;
#pragma unroll
    for (int i = 0; i < 8; ++i) {
      const int c = (t >> 6) + 8 * i;
      if (c0 + c < C) {
        const int row = rm(c0 + c);
        const float v = sm[r * 65 + c];
        const u16 h = f2bf(v);
        dhi[(size_t)row * ldd + r0 + r] = h;
        if (dlo) dlo[(size_t)row * ldd + r0 + r] = f2bf(v - bf2f(h));
      }
    }
  }
}
struct RmId { __device__ int operator()(int c) const { return c; } };
struct RmIn {
  __device__ int operator()(int c) const {
    if (c < 384) return c;
    if (c < 640) return 512 + (c - 384);
    if (c < 704) return 384 + (c - 640);
    if (c < 720) return 448 + (c - 704);
    if (c < 1232) return 768 + (c - 720);
    if (c < 1744) return 1280 + (c - 1232);
    if (c < 2256) return 1792 + (c - 1744);
    return 2304 + (c - 2256);
  }
};
struct RmUp { __device__ int operator()(int c) const { return c < DFF ? ((c >> 7) * 256 + (c & 127)) : (((c - DFF) >> 7) * 256 + 128 + ((c - DFF) & 127)); } };

__device__ __forceinline__ void s5_pw(float lre, float lim, float step, int e, float& pr, float& pi) {
  const float a = (float)e * step;
  const float mag = __expf(a * lre);
  float rev = a * lim * 0.15915494309189535f;
  rev -= floorf(rev);
  const float ang = rev * 6.283185307179586f;
  pr = mag * __cosf(ang);
  pi = mag * __sinf(ang);
}
__device__ __forceinline__ void s5_bbar(float lre, float lim, float step, float br, float bi, float& or_, float& oi) {
  float pr, pi;
  s5_pw(lre, lim, step, 1, pr, pi);
  const float nr = pr - 1.f, ni = pi;
  const float den = lre * lre + lim * lim;
  const float qr = (nr * lre + ni * lim) / den, qi = (ni * lre - nr * lim) / den;
  or_ = qr * br - qi * bi;
  oi = qr * bi + qi * br;
}

__device__ __forceinline__ void phase_prep(const P& p, int l, char* smem) {
  char* ws = opaque_p(p.ws);
  float* sm = (float*)smem;
  const float* w_in = p.in(2) + (size_t)l * DM * INW;
  const float* w_uq = p.in(5) + (size_t)l * 384 * 512;
  const float* w_qidx = p.in(8) + (size_t)l * 384 * 1024;
  const float* w_glu = p.in(17) + (size_t)l * 512 * 512;
  const float* w_br = p.in(19) + (size_t)l * 3 * 512 * DM;
  const float* w_out = p.in(20) + (size_t)l * DM * DM;
  const float* w_up = p.in(23) + (size_t)l * DM * 2 * DFF;
  const float* w_down = p.in(26) + (size_t)l * DFF * DM;
  const int n1 = 32 * 44, n2 = 32 * 96, n3 = 6 * 8, n4 = 6 * 16, n5 = 8 * 8, n6 = 3 * 8 * 32, n7 = 32 * 32, n8 = 32 * 176, n9 = 88 * 32;
  const int ntot = n1 + n2 + n3 + n4 + n5 + n6 + n7 + n8 + n9;
  for (int it = opaque_s((int)blockIdx.x); it < ntot; it += gridDim.x) {
    int i = it;
    if (i < n1) { tr_tile(w_in, INW, NA, (u16*)(ws + O_WINHI), NOSPLIT ? nullptr : (u16*)(ws + O_WINLO), DM, RmIn(), i / 44, i % 44, sm); continue; }
    i -= n1;
    if (i < n2) { tr_tile(w_in + NA, INW, 6144, (u16*)(ws + O_WG), nullptr, DM, RmId(), i / 96, i % 96, sm); continue; }
    i -= n2;
    if (i < n3) { tr_tile(w_uq, 512, 512, (u16*)(ws + O_WQHI), NOSPLIT ? nullptr : (u16*)(ws + O_WQLO), 384, RmId(), i / 8, i % 8, sm); continue; }
    i -= n3;
    if (i < n4) { tr_tile(w_qidx, 1024, 1024, (u16*)(ws + O_WQHI) + 512 * 384, NOSPLIT ? nullptr : (u16*)(ws + O_WQLO) + 512 * 384, 384, RmId(), i / 16, i % 16, sm); continue; }
    i -= n4;
    if (i < n5) { tr_tile(w_glu, 512, 512, (u16*)(ws + O_WGLU), nullptr, 512, RmId(), i / 8, i % 8, sm); continue; }
    i -= n5;
    if (i < n6) { const int br = i / 256, j = i % 256; tr_tile(w_br + (size_t)br * 512 * DM, DM, DM, (u16*)(ws + O_WBR) + (size_t)br * DM * 512, nullptr, 512, RmId(), j / 32, j % 32, sm); continue; }
    i -= n6;
    if (i < n7) { tr_tile(w_out, DM, DM, (u16*)(ws + O_WOUT), nullptr, DM, RmId(), i / 32, i % 32, sm); continue; }
    i -= n7;
    if (i < n8) { tr_tile(w_up, 2 * DFF, 2 * DFF, (u16*)(ws + O_WUP), nullptr, DM, RmUp(), i / 176, i % 176, sm); continue; }
    i -= n8;
    { tr_tile(w_down, DM, DM, (u16*)(ws + O_WDOWN), nullptr, DFF, RmId(), i / 32, i % 32, sm); }
  }
  const int gtid = opaque_s((int)blockIdx.x) * NTH + opaque(threadIdx.x), gsz = gridDim.x * NTH;
  for (int i = gtid; i < (NAP - NA) * DM; i += gsz) {
    ((u16*)(ws + O_WINHI))[(size_t)464 * DM + i] = 0;
    ((u16*)(ws + O_WINLO))[(size_t)464 * DM + i] = 0;
  }
  const float* w_uk = p.in(6) + (size_t)l * 256 * 512;
  for (int i = gtid; i < 256 * 512; i += gsz) ((u16*)(ws + O_WUK))[i] = f2bf(w_uk[i]);
  const float* w_uv = p.in(7) + (size_t)l * 256 * 512;
  for (int i = gtid; i < 8 * 64 * 256; i += gsz) {
    const int cp = i & 255, d = (i >> 8) & 63, h = i >> 14;
    const int s = cp >> 5, e = cp & 31, quad = e >> 3, j = e & 7;
    const int c = 32 * s + (j < 4 ? quad * 4 + j : 16 + quad * 4 + (j - 4));
    ((u16*)(ws + O_WUVP))[i] = f2bf(w_uv[(size_t)c * 512 + h * 64 + d]);
  }
  for (int i = gtid; i < 512 * 2048; i += gsz) {
    const int n = i >> 11, k = i & 2047, h = n >> 6, d = n & 63, kh = k >> 8, c = k & 255;
    ((u16*)(ws + O_WUVBD))[i] = (kh == h) ? f2bf(w_uv[(size_t)c * 512 + h * 64 + d]) : (u16)0;
  }
  const float* lam_re = p.in(9) + l * 32 * 64;
  const float* lam_im = p.in(10) + l * 32 * 64;
  const float* log_step = p.in(11) + l * 32;
  const float* b_re = p.in(12) + (size_t)l * 32 * 64 * 16;
  const float* b_im = p.in(13) + (size_t)l * 32 * 64 * 16;
  const float* c_re = p.in(14) + (size_t)l * 32 * 16 * 64;
  const float* c_im = p.in(15) + (size_t)l * 32 * 16 * 64;
  for (int i = gtid; i < 32 * 32 * 256; i += gsz) {
    const int pi_ = i & 15, po = (i >> 4) & 15, dl = (i >> 8) & 31, g = i >> 13;
    const float step = __expf(log_step[g]);
    float s = 0.f;
    for (int n = 0; n < 64; ++n) {
      const float lre = lam_re[g * 64 + n], lim = lam_im[g * 64 + n];
      float pr, pim, bbr, bbi;
      s5_pw(lre, lim, step, dl, pr, pim);
      s5_bbar(lre, lim, step, b_re[(g * 64 + n) * 16 + pi_], b_im[(g * 64 + n) * 16 + pi_], bbr, bbi);
      const float wr_ = pr * bbr - pim * bbi, wi_ = pr * bbi + pim * bbr;
      s += c_re[(g * 16 + po) * 64 + n] * wr_ - c_im[(g * 16 + po) * 64 + n] * wi_;
    }
    ((u16*)(ws + O_KTAB))[i] = f2bf(s);
  }
  for (int i = gtid; i < 32 * 512 * 128; i += gsz) {
    const int col = i & 127, row = (i >> 7) & 511, g = i >> 16;
    const int n = col & 63, ii = row >> 4, po = row & 15;
    const float step = __expf(log_step[g]);
    float pr, pim;
    s5_pw(lam_re[g * 64 + n], lam_im[g * 64 + n], step, ii + 1, pr, pim);
    const float cr = c_re[(g * 16 + po) * 64 + n], ci = c_im[(g * 16 + po) * 64 + n];
    const float v = (col < 64) ? (cr * pr - ci * pim) : -(cr * pim + ci * pr);
    ((u16*)(ws + O_CM))[i] = f2bf(v);
  }
  for (int i = gtid; i < 32 * 128 * 512; i += gsz) {
    const int k = i & 511, row = (i >> 9) & 127, g = i >> 16;
    const int n = row & 63, j = k >> 4, pi_ = k & 15;
    const float step = __expf(log_step[g]);
    const float lre = lam_re[g * 64 + n], lim = lam_im[g * 64 + n];
    float pr, pim, bbr, bbi;
    s5_pw(lre, lim, step, 31 - j, pr, pim);
    s5_bbar(lre, lim, step, b_re[(g * 64 + n) * 16 + pi_], b_im[(g * 64 + n) * 16 + pi_], bbr, bbi);
    const float v = (row < 64) ? (pr * bbr - pim * bbi) : (pr * bbi + pim * bbr);
    ((u16*)(ws + O_BM))[i] = f2bf(v);
  }
  for (int i = gtid; i < 32 * 64; i += gsz) {
    const int g = i >> 6;
    float pr, pim;
    s5_pw(lam_re[i], lam_im[i], __expf(log_step[g]), 32, pr, pim);
    ((float2*)(ws + O_LAML))[i] = make_float2(pr, pim);
  }
  if (l == 0) {
    const float* rel = p.in(1);
    for (int i = gtid; i < 16 * 2048; i += gsz) {
      const int dist = i & 2047, hh = i >> 11;
      int bk;
      if (dist < 16) bk = dist;
      else {
        bk = 16 + (int)(__log2f((float)dist * 0.0625f) * (16.f / 3.f));
        if (bk > 31) bk = 31;
      }
      ((float*)(ws + O_BIASD))[i] = rel[bk * 16 + hh];
    }
    const float4* x4 = (const float4*)p.in(0);
    for (size_t i = gtid; i < (size_t)NTOK * DM / 4; i += gsz) {
      const float4 v = x4[i];
      const u16 h0 = f2bf(v.x), h1 = f2bf(v.y), h2 = f2bf(v.z), h3 = f2bf(v.w);
      ((uint2*)(ws + O_XH))[i] = make_uint2((uint32_t)h0 | ((uint32_t)h1 << 16), (uint32_t)h2 | ((uint32_t)h3 << 16));
      if (!NOSPLIT) ((uint2*)(ws + O_XL))[i] = make_uint2(pack2(v.x - bf2f(h0), v.y - bf2f(h1)), pack2(v.z - bf2f(h2), v.w - bf2f(h3)));
    }
  }
}

__device__ __forceinline__ void phase_gemm_in(const P& p, char* smem) {
  char* ws = opaque_p(p.ws);
  const int ntiles = 128 * 11;
  for (int it = xcd_first_tile(); it < ntiles; it += gridDim.x) {
    const int mb = it / 44, rem = it - mb * 44, tn = rem >> 2, tm = mb * 4 + (rem & 3);
    Acc256 acc;
    zero256(acc);
    const u16* ah = (const u16*)(ws + O_XH) + (size_t)tm * 256 * DM;
    const u16* al = (const u16*)(ws + O_XL) + (size_t)tm * 256 * DM;
    const u16* bh = (const u16*)(ws + O_WINHI) + (size_t)tn * 256 * DM;
    const u16* bl = (const u16*)(ws + O_WINLO) + (size_t)tn * 256 * DM;
    if (NOSPLIT == 0 && tn < 2) {
      gemm256(acc, al, DM, bh, DM, DM, smem);
      gemm256(acc, ah, DM, bl, DM, DM, smem);
    }
    gemm256(acc, ah, DM, bh, DM, DM, smem);
    const int m0 = tm * 256, n0 = tn * 256;
    epi256(acc, [&](int lr, int lc, f32x4 v) {
      const int col = n0 + lc;
      const int t0 = m0 + lr;
      if (col < 384) {
        float* d = (float*)(ws + O_CQ);
#pragma unroll
        for (int r = 0; r < 4; ++r) d[(size_t)(t0 + r) * 384 + col] = v[r];
      } else if (col < 448) {
        float* d = (float*)(ws + O_KIDX);
#pragma unroll
        for (int r = 0; r < 4; ++r) d[(size_t)(t0 + r) * 64 + col - 384] = v[r];
      } else if (col < 464) {
        float* d = (float*)(ws + O_WIDX);
#pragma unroll
        for (int r = 0; r < 4; ++r) d[(size_t)(t0 + r) * 16 + col - 448] = v[r];
      } else if (col < 512) {
      } else if (col < 768) {
        float* d = (float*)(ws + O_CKV);
#pragma unroll
        for (int r = 0; r < 4; ++r) d[(size_t)(t0 + r) * 256 + col - 512] = v[r];
      } else if (col < 1280) {
        u16* d = (u16*)(ws + O_U);
#pragma unroll
        for (int r = 0; r < 4; ++r) d[(size_t)(t0 + r) * 512 + col - 768] = f2bf(v[r]);
      } else if (col < 1792) {
        float* d = (float*)(ws + O_QC);
#pragma unroll
        for (int r = 0; r < 4; ++r) d[(size_t)(t0 + r) * 512 + col - 1280] = v[r];
      } else if (col < 2304) {
        float* d = (float*)(ws + O_KC);
        u16* d2 = (u16*)(ws + O_KCB);
#pragma unroll
        for (int r = 0; r < 4; ++r) {
          d[(size_t)(t0 + r) * 512 + col - 1792] = v[r];
          d2[(size_t)(t0 + r) * 512 + col - 1792] = f2bf(v[r]);
        }
      } else {
        const int c = col - 2304, h = c >> 6, dd = c & 63, b = t0 >> 11, tt = t0 & 2047;
        u16* d = (u16*)(ws + O_VT) + ((size_t)((b * 8 + h) * 64 + dd)) * T + tt;
        *(uint2*)d = make_uint2(pack2(v[0], v[1]), pack2(v[2], v[3]));
      }
    });
  }
}

struct S5UAddr {
  const u16* base;
  int row0;
  __device__ __forceinline__ const void* operator()(int row, int kt, int c8) const {
    const int rc = row0 + row;
    const int j = kt * 4 + (c8 >> 1), pi0 = (c8 & 1) * 8;
    return base + ((size_t)rc * 32 + j) * 512 + pi0;
  }
};
struct S5ToepAddr {
  const u16* ktab;
  int n0;
  __device__ __forceinline__ const void* operator()(int row, int kt, int c8) const {
    const int n = n0 + row, i = n >> 4, po = n & 15;
    const int j = kt * 4 + (c8 >> 1), pi0 = (c8 & 1) * 8;
    if (j > i) return nullptr;
    return ktab + ((i - j) * 16 + po) * 16 + pi0;
  }
};

__device__ __forceinline__ void phase_p2(const P& p, int l, char* smem) {
  char* ws = opaque_p(p.ws);
  const int tid = opaque(threadIdx.x), lane = tid & 63, wid = tid >> 6;
  const float* cq_gain = p.in(3) + l * 384;
  const float* ckv_gain = p.in(4) + l * 256;
  const int n_tok = NTOK / 64, n_km = 16 * 8 * 8, n_g1 = 32 * 8;
  for (int it = opaque_s((int)blockIdx.x); it < n_tok + n_km + n_g1; it += gridDim.x) {
    if (it < n_tok) {
      const int b = it >> 5, tc = it & 31, t0g = b * T + tc * 64;
      u16* sT = (u16*)smem;
      __syncthreads();
      for (int i = 0; i < 8; ++i) {
        const int tl = wid * 8 + i, t = t0g + tl;
        {
          const float* src = (const float*)(ws + O_CQ) + (size_t)t * 384;
          float v[6], ss = 0.f;
#pragma unroll
          for (int j = 0; j < 6; ++j) { v[j] = src[lane + 64 * j]; ss += v[j] * v[j]; }
          ss = wave_sum(ss);
          const float rs = rsqrtf(ss * (1.f / 384.f) + 1e-5f);
#pragma unroll
          for (int j = 0; j < 6; ++j) {
            const float y = v[j] * rs * cq_gain[lane + 64 * j];
            const u16 h = f2bf(y);
            ((u16*)(ws + O_CQNHI))[(size_t)t * 384 + lane + 64 * j] = h;
            if (!NOSPLIT) ((u16*)(ws + O_CQNLO))[(size_t)t * 384 + lane + 64 * j] = f2bf(y - bf2f(h));
          }
        }
        {
          const float* src = (const float*)(ws + O_CKV) + (size_t)t * 256;
          float v[4], ss = 0.f;
#pragma unroll
          for (int j = 0; j < 4; ++j) { v[j] = src[lane + 64 * j]; ss += v[j] * v[j]; }
          ss = wave_sum(ss);
          const float rs = rsqrtf(ss * (1.f / 256.f) + 1e-5f);
#pragma unroll
          for (int j = 0; j < 4; ++j) {
            const u16 h = f2bf(v[j] * rs * ckv_gain[lane + 64 * j]);
            ((u16*)(ws + O_CKVN))[(size_t)t * 256 + lane + 64 * j] = h;
            sT[tl * 258 + lane + 64 * j] = h;
          }
        }
        {
          const float y = ((const float*)(ws + O_KIDX))[(size_t)t * 64 + lane];
          const u16 h = f2bf(y);
          ((u16*)(ws + O_KIHI))[(size_t)t * 64 + lane] = h;
          if (!NOSPLIT) ((u16*)(ws + O_KILO))[(size_t)t * 64 + lane] = f2bf(y - bf2f(h));
        }
      }
      __syncthreads();
      {
        const int c = tid & 255, half = tid >> 8;
        u16* dst = (u16*)(ws + O_CKVNT) + ((size_t)(b * 256 + c)) * T + tc * 64;
#pragma unroll
        for (int jj = 0; jj < 4; ++jj) {
          const int j = half * 4 + jj;
          U4 u;
#pragma unroll
          for (int e = 0; e < 8; ++e) u.s[e] = sT[(j * 8 + e) * 258 + c];
          *(uint4*)(dst + j * 8) = u.v;
        }
      }
    } else if (it < n_tok + n_km) {
      const int i = it - n_tok, h = i & 7, n = (i >> 3) & 7, b = i >> 6;
      float* sm = (float*)smem;
      const int d = tid & 63, tq = tid >> 6;
      const float* src = (const float*)(ws + O_KC) + ((size_t)(b * T + n * 256 + tq * 32)) * 512 + h * 64 + d;
      float s = 0.f;
      for (int j = 0; j < 32; ++j) s += src[(size_t)j * 512];
      __syncthreads();
      sm[tq * 64 + d] = s;
      __syncthreads();
      if (tid < 64) {
        float a = 0.f;
#pragma unroll
        for (int j = 0; j < 8; ++j) a += sm[j * 64 + tid];
        ((float*)(ws + O_KMEAN))[((b * 8 + n) * 8 + h) * 64 + tid] = a * (1.f / 256.f);
      }
    } else {
      const int i = it - n_tok - n_km, g = i >> 3, tm = i & 7;
      f32x4 acc[2][4];
      zero_acc(acc);
      S5UAddr fa{(const u16*)(ws + O_U) + g * 16, tm * 128};
      RowMajor fb{(const u16*)(ws + O_BM) + (size_t)g * 128 * 512, 512};
      TileLd<S5UAddr> la(fa);
      TileLd<RowMajor> lb(fb);
      gemm_loop(acc, la, lb, 8, smem);
      float* dst = (float*)(ws + O_SLOC) + (size_t)g * 1024 * 128;
      epi_each(acc, [&](int lr, int lc, f32x4 v) {
#pragma unroll
        for (int r = 0; r < 4; ++r) dst[(size_t)(tm * 128 + lr + r) * 128 + lc] = v[r];
      });
    }
  }
}

__device__ __forceinline__ void phase_p3(const P& p, char* smem) {
  char* ws = opaque_p(p.ws);
  const int tid = opaque(threadIdx.x);
  const int n_g = 128 * 6, n_gate = NTOK * 8 / NTH, n_scan = 32 * 16 * 64 / NTH;
  for (int it = opaque_s((int)blockIdx.x); it < n_g; it += gridDim.x) {
    {
      const int tn = it % 6, tm = it / 6;
      Acc256 acc;
      zero256(acc);
      const u16* ah = (const u16*)(ws + O_CQNHI) + (size_t)tm * 256 * 384;
      const u16* al = (const u16*)(ws + O_CQNLO) + (size_t)tm * 256 * 384;
      const u16* bh = (const u16*)(ws + O_WQHI) + (size_t)tn * 256 * 384;
      const u16* bl = (const u16*)(ws + O_WQLO) + (size_t)tn * 256 * 384;
      if (NOSPLIT == 0) {
        gemm256(acc, al, 384, bh, 384, 384, smem);
        gemm256(acc, ah, 384, bl, 384, 384, smem);
      }
      gemm256(acc, ah, 384, bh, 384, 384, smem);
      const int m0 = tm * 256, n0 = tn * 256;
      epi256(acc, [&](int lr, int lc, f32x4 v) {
        const int col = n0 + lc, t0 = m0 + lr;
        if (col < 512) {
#pragma unroll
          for (int r = 0; r < 4; ++r) ((u16*)(ws + O_Q))[(size_t)(t0 + r) * 512 + col] = f2bf(v[r]);
        } else {
#pragma unroll
          for (int r = 0; r < 4; ++r) {
            const float y = v[r] * 0.125f;
            const u16 h = f2bf(y);
            ((u16*)(ws + O_QIHI))[(size_t)(t0 + r) * 1024 + col - 512] = h;
            if (!NOSPLIT) ((u16*)(ws + O_QILO))[(size_t)(t0 + r) * 1024 + col - 512] = f2bf(y - bf2f(h));
          }
        }
      });
    }
  }
  for (int it = opaque_s((int)blockIdx.x); it < n_gate; it += gridDim.x) {
    {
      const int idx = it * NTH + tid;
      const int h = idx & 7, t = idx >> 3, b = t >> 11, own = (t & 2047) >> 8;
      const float4* q4 = (const float4*)((const float*)(ws + O_QC) + (size_t)t * 512 + h * 64);
      float v0 = -INFINITY, v1 = -INFINITY, v2 = -INFINITY;
      int i0 = -1, i1 = -1, i2 = -1;
      for (int n = 0; n < own; ++n) {
        const float4* k4 = (const float4*)((const float*)(ws + O_KMEAN) + ((b * 8 + n) * 8 + h) * 64);
        float s = 0.f;
#pragma unroll
        for (int j = 0; j < 16; ++j) {
          const float4 a = q4[j], c = k4[j];
          s += a.x * c.x + a.y * c.y + a.z * c.z + a.w * c.w;
        }
        if (s > v0) { v2 = v1; i2 = i1; v1 = v0; i1 = i0; v0 = s; i0 = n; }
        else if (s > v1) { v2 = v1; i2 = i1; v1 = s; i1 = n; }
        else if (s > v2) { v2 = s; i2 = n; }
      }
      unsigned m = 0;
      if (i0 >= 0) m |= 1u << i0;
      if (i1 >= 0) m |= 1u << i1;
      if (i2 >= 0) m |= 1u << i2;
      ((unsigned char*)(ws + O_MSEL))[idx] = (unsigned char)m;
    }
  }
  for (int it = opaque_s((int)blockIdx.x); it < n_scan; it += gridDim.x) {
    {
      const int idx = it * NTH + tid;
      const int n = idx & 63, b = (idx >> 6) & 15, g = idx >> 10;
      const float2 lm = ((const float2*)(ws + O_LAML))[g * 64 + n];
      const float* sl = (const float*)(ws + O_SLOC) + ((size_t)g * 1024 + b * 64) * 128;
      u16* sp = (u16*)(ws + O_SPREV) + ((size_t)g * 1024 + b * 64) * 128;
      float sr = 0.f, si = 0.f;
      for (int c = 0; c < 64; ++c) {
        sp[c * 128 + n] = f2bf(sr);
        sp[c * 128 + 64 + n] = f2bf(si);
        const float ar = sl[c * 128 + n], ai = sl[c * 128 + 64 + n];
        const float nr = lm.x * sr - lm.y * si + ar, ni = lm.x * si + lm.y * sr + ai;
        sr = nr;
        si = ni;
      }
    }
  }
}

template <bool DSA>
__device__ __forceinline__ void attn_item(const P& p, int b, int qb, int h, char* smem) {
  constexpr int DK = DSA ? 256 : 64, DVP = DSA ? 128 : 64, NPASS = DSA ? 2 : 1, KS = DK / 32, LDK = DK + 8, LDV = 64 + 8, NMT = DVP / 16;
  constexpr int NKC = 64 * DK / 8 / NTH;
  constexpr int NVC = DVP * 8 / NTH;
  char* ws = opaque_p(p.ws);
  const int tid = opaque(threadIdx.x), lane = tid & 63, wid = tid >> 6, fr = lane & 15, fq = lane >> 4;
  u16* Ks = (u16*)smem;
  u16* Vt = (u16*)(smem + 64 * LDK * 2);
  float* bias = (float*)(smem + 64 * LDK * 2 + DVP * LDV * 2);
  const int q0 = qb * 128, qpos = q0 + wid * 16 + fr;
  const size_t tq = (size_t)b * T + qpos;
  __syncthreads();
  {
    const float* bsrc = (const float*)(ws + O_BIASD) + (size_t)(DSA ? h : 8 + h) * 2048;
    for (int i = tid; i < 2048; i += NTH) bias[i] = bsrc[i];
  }
  bf16x8 qf[KS];
  if (DSA) {
    const u16* wuk = (const u16*)(ws + O_WUK);
    const u16* qsrc = (const u16*)(ws + O_Q) + tq * 512 + h * 64;
    U4 qb0, qb1;
    qb0.v = *(const uint4*)(qsrc + fq * 8);
    qb1.v = *(const uint4*)(qsrc + 32 + fq * 8);
#pragma unroll
    for (int s = 0; s < 8; ++s) {
      f32x4 a0 = {0.f, 0.f, 0.f, 0.f}, a1 = {0.f, 0.f, 0.f, 0.f};
      {
        const u16* w0 = wuk + ((size_t)(32 * s + fr) * 8 + h) * 64;
        const u16* w1 = wuk + ((size_t)(32 * s + 16 + fr) * 8 + h) * 64;
        U4 x0, x1, y0, y1;
        x0.v = *(const uint4*)(w0 + fq * 8);
        x1.v = *(const uint4*)(w0 + 32 + fq * 8);
        y0.v = *(const uint4*)(w1 + fq * 8);
        y1.v = *(const uint4*)(w1 + 32 + fq * 8);
        a0 = mfma16(x0.h, qb0.h, a0);
        a0 = mfma16(x1.h, qb1.h, a0);
        a1 = mfma16(y0.h, qb0.h, a1);
        a1 = mfma16(y1.h, qb1.h, a1);
      }
      U4 o;
      o.w[0] = pack2(a0[0] * 0.125f, a0[1] * 0.125f);
      o.w[1] = pack2(a0[2] * 0.125f, a0[3] * 0.125f);
      o.w[2] = pack2(a1[0] * 0.125f, a1[1] * 0.125f);
      o.w[3] = pack2(a1[2] * 0.125f, a1[3] * 0.125f);
      qf[s] = o.h;
      __builtin_amdgcn_sched_barrier(0);
    }
  } else {
    const float* qsrc = (const float*)(ws + O_QC) + tq * 512 + h * 64;
#pragma unroll
    for (int s = 0; s < KS; ++s) {
      const float4 a = *(const float4*)(qsrc + 32 * s + fq * 8), c = *(const float4*)(qsrc + 32 * s + fq * 8 + 4);
      U4 o;
      o.w[0] = pack2(a.x * 0.125f, a.y * 0.125f);
      o.w[1] = pack2(a.z * 0.125f, a.w * 0.125f);
      o.w[2] = pack2(c.x * 0.125f, c.y * 0.125f);
      o.w[3] = pack2(c.z * 0.125f, c.w * 0.125f);
      qf[s] = o.h;
    }
  }
  unsigned msel = 0;
  const uint32_t* mrow = nullptr;
  if (DSA) mrow = (const uint32_t*)(ws + O_MASK) + tq * 64;
  else msel = ((const unsigned char*)(ws + O_MSEL))[tq * 8 + h];
  const int ownblk = q0 >> 8;
  const u16* kg = DSA ? (const u16*)(ws + O_CKVN) + (size_t)b * T * 256 : (const u16*)(ws + O_KCB) + (size_t)b * T * 512 + h * 64;
  const int kld = DSA ? 256 : 512;
  const int nkt = 2 * qb + 2;
  f32x4 oo[4];
#pragma unroll
  for (int i = 0; i < 4; ++i) oo[i] = f32x4{0.f, 0.f, 0.f, 0.f};

#pragma unroll 1
  for (int pass = 0; pass < NPASS; ++pass) {
    const u16* vg = DSA ? (const u16*)(ws + O_CKVNT) + ((size_t)b * 256 + pass * 128) * T : (const u16*)(ws + O_VT) + (size_t)(b * 8 + h) * 64 * T;
    f32x4 ot[NMT];
#pragma unroll
    for (int i = 0; i < NMT; ++i) ot[i] = f32x4{0.f, 0.f, 0.f, 0.f};
    float m_run = -1e30f, l_run = 0.f;
    uint4 k0 = make_uint4(0, 0, 0, 0), k1 = k0, k2 = k0, k3 = k0, v0 = k0, v1 = k0;
#define KADDR(i, ktt) (kg + (size_t)((ktt) * 64 + (tid + NTH * (i)) / (DK / 8)) * kld + ((tid + NTH * (i)) % (DK / 8)) * 8)
#define VADDR(i, ktt) (vg + (size_t)((tid + NTH * (i)) >> 3) * T + (ktt) * 64 + ((tid + NTH * (i)) & 7) * 8)
#define KSADDR(i) (Ks + ((tid + NTH * (i)) / (DK / 8)) * LDK + ((tid + NTH * (i)) % (DK / 8)) * 8)
#define VSADDR(i) (Vt + ((tid + NTH * (i)) >> 3) * LDV + ((tid + NTH * (i)) & 7) * 8)
#define TILE_LOAD(ktt)                                          \
  do {                                                          \
    k0 = *(const uint4*)KADDR(0, ktt);                          \
    if (NKC > 1) k1 = *(const uint4*)KADDR(1, ktt);             \
    if (NKC > 2) k2 = *(const uint4*)KADDR(2, ktt);             \
    if (NKC > 3) k3 = *(const uint4*)KADDR(3, ktt);             \
    v0 = *(const uint4*)VADDR(0, ktt);                          \
    if (NVC > 1) v1 = *(const uint4*)VADDR(1, ktt);             \
  } while (0)
    TILE_LOAD(0);
#pragma unroll 1
    for (int kt = 0; kt < nkt; ++kt) {
      __syncthreads();
      *(uint4*)KSADDR(0) = k0;
      if (NKC > 1) *(uint4*)KSADDR(1) = k1;
      if (NKC > 2) *(uint4*)KSADDR(2) = k2;
      if (NKC > 3) *(uint4*)KSADDR(3) = k3;
      *(uint4*)VSADDR(0) = v0;
      if (NVC > 1) *(uint4*)VSADDR(1) = v1;
      __syncthreads();
      if (kt + 1 < nkt) TILE_LOAD(kt + 1);
      f32x4 st[4];
#pragma unroll
      for (int m = 0; m < 4; ++m) {
        st[m] = f32x4{0.f, 0.f, 0.f, 0.f};
        const u16* krow = Ks + (16 * m + fr) * LDK;
#pragma unroll
        for (int s = 0; s < KS; ++s) {
          U4 a;
          if (DSA) {
            const uint2 x = *(const uint2*)(krow + 32 * s + fq * 4), y = *(const uint2*)(krow + 32 * s + 16 + fq * 4);
            a.w[0] = x.x; a.w[1] = x.y; a.w[2] = y.x; a.w[3] = y.y;
          } else {
            a.v = *(const uint4*)(krow + 32 * s + fq * 8);
          }
          st[m] = mfma16(a.h, qf[s], st[m]);
        }
        __builtin_amdgcn_sched_barrier(0);
      }
      uint32_t mw0 = 0, mw1 = 0;
      bool blk_ok = false;
      const int kblk = kt >> 2;
      if (DSA) { const uint2 mm = *(const uint2*)(mrow + 2 * kt); mw0 = mm.x; mw1 = mm.y; }
      else blk_ok = (kblk < ownblk) ? ((msel >> kblk) & 1u) : true;
      float mx = m_run;
      unsigned okm = 0;
#pragma unroll
      for (int m = 0; m < 4; ++m)
#pragma unroll
        for (int r = 0; r < 4; ++r) {
          const int kl = 16 * m + fq * 4 + r, key = kt * 64 + kl;
          bool a;
          if (DSA) a = (((m < 2 ? mw0 : mw1) >> ((m & 1) * 16 + fq * 4 + r)) & 1u) != 0;
          else a = blk_ok && (key <= qpos);
          if (a) okm |= 1u << (m * 4 + r);
          const int dist = qpos - key;
          const float s = st[m][r] + bias[dist < 0 ? 0 : dist];
          st[m][r] = s;
          if (a) mx = fmaxf(mx, s);
        }
      mx = fmaxf(mx, __shfl_xor(mx, 16));
      mx = fmaxf(mx, __shfl_xor(mx, 32));
      const float alpha = __expf(m_run - mx);
      float ls = 0.f;
#pragma unroll
      for (int m = 0; m < 4; ++m)
#pragma unroll
        for (int r = 0; r < 4; ++r) {
          const float pv = ((okm >> (m * 4 + r)) & 1u) ? __expf(st[m][r] - mx) : 0.f;
          st[m][r] = pv;
          ls += pv;
        }
      l_run = l_run * alpha + ls;
      m_run = mx;
#pragma unroll
      for (int i = 0; i < NMT; ++i) ot[i] *= alpha;
#pragma unroll
      for (int s = 0; s < 2; ++s) {
        U4 pb;
        pb.w[0] = pack2(st[2 * s][0], st[2 * s][1]);
        pb.w[1] = pack2(st[2 * s][2], st[2 * s][3]);
        pb.w[2] = pack2(st[2 * s + 1][0], st[2 * s + 1][1]);
        pb.w[3] = pack2(st[2 * s + 1][2], st[2 * s + 1][3]);
#pragma unroll
        for (int mt = 0; mt < NMT; ++mt) {
          const u16* vrow = Vt + (16 * mt + fr) * LDV + 32 * s;
          const uint2 x = *(const uint2*)(vrow + fq * 4), y = *(const uint2*)(vrow + 16 + fq * 4);
          U4 a;
          a.w[0] = x.x; a.w[1] = x.y; a.w[2] = y.x; a.w[3] = y.y;
          ot[mt] = mfma16(a.h, pb.h, ot[mt]);
          if ((mt & 3) == 3) __builtin_amdgcn_sched_barrier(0);
        }
      }
    }
    l_run += __shfl_xor(l_run, 16);
    l_run += __shfl_xor(l_run, 32);
    const float inv = 1.f / l_run;
    if (DSA) {
      const u16* wv = (const u16*)(ws + O_WUVP) + (size_t)h * 64 * 256 + pass * 128;
#pragma unroll
      for (int s = 0; s < 4; ++s) {
        U4 pb;
        pb.w[0] = pack2(ot[2 * s][0] * inv, ot[2 * s][1] * inv);
        pb.w[1] = pack2(ot[2 * s][2] * inv, ot[2 * s][3] * inv);
        pb.w[2] = pack2(ot[2 * s + 1][0] * inv, ot[2 * s + 1][1] * inv);
        pb.w[3] = pack2(ot[2 * s + 1][2] * inv, ot[2 * s + 1][3] * inv);
#pragma unroll
        for (int mt = 0; mt < 4; ++mt) {
          U4 a;
          a.v = *(const uint4*)(wv + (size_t)(16 * mt + fr) * 256 + 32 * s + fq * 8);
          oo[mt] = mfma16(a.h, pb.h, oo[mt]);
        }
        __builtin_amdgcn_sched_barrier(0);
      }
    } else {
      u16* dst = (u16*)(ws + O_OC) + tq * 512 + h * 64;
#pragma unroll
      for (int mt = 0; mt < NMT; ++mt)
        *(uint2*)(dst + 16 * mt + fq * 4) = make_uint2(pack2(ot[mt][0] * inv, ot[mt][1] * inv), pack2(ot[mt][2] * inv, ot[mt][3] * inv));
    }
  }
  if (DSA) {
    u16* dst = (u16*)(ws + O_OA) + tq * 512 + h * 64;
#pragma unroll
    for (int mt = 0; mt < 4; ++mt) *(uint2*)(dst + 16 * mt + fq * 4) = make_uint2(pack2(oo[mt][0], oo[mt][1]), pack2(oo[mt][2], oo[mt][3]));
  }
}


__device__ __forceinline__ void dsa_item(const P& p, int b, int qb32, char* smem) {
  constexpr int LDK = 264, LDV = 72;
  char* ws = opaque_p(p.ws);
  const int tid = opaque(threadIdx.x), lane = tid & 63, h = tid >> 6, fr = lane & 15, fq = lane >> 4;
  u16* Ks = (u16*)smem;
  u16* Vt = (u16*)(smem + 33792);
  const float* bias = (const float*)(smem + 52224) + h * 2048;
  const int q0 = qb32 * 32;
  const int qpos0 = q0 + fr, qpos1 = q0 + 16 + fr;
  const size_t tq0 = (size_t)b * T + qpos0, tq1 = tq0 + 16;
  bf16x8 qf0[8], qf1[8];
  {
    const u16* wuk = (const u16*)(ws + O_WUK);
    const u16* qs0 = (const u16*)(ws + O_Q) + tq0 * 512 + h * 64;
    const u16* qs1 = qs0 + 16 * 512;
    U4 qa0, qa1, qb0, qb1;
    qa0.v = *(const uint4*)(qs0 + fq * 8);
    qa1.v = *(const uint4*)(qs0 + 32 + fq * 8);
    qb0.v = *(const uint4*)(qs1 + fq * 8);
    qb1.v = *(const uint4*)(qs1 + 32 + fq * 8);
#pragma unroll
    for (int s = 0; s < 8; ++s) {
      f32x4 a0 = {0.f, 0.f, 0.f, 0.f}, a1 = a0, c0 = a0, c1 = a0;
      const u16* w0 = wuk + ((size_t)(32 * s + fr) * 8 + h) * 64;
      const u16* w1 = wuk + ((size_t)(32 * s + 16 + fr) * 8 + h) * 64;
      U4 x0, x1, y0, y1;
      x0.v = *(const uint4*)(w0 + fq * 8);
      x1.v = *(const uint4*)(w0 + 32 + fq * 8);
      y0.v = *(const uint4*)(w1 + fq * 8);
      y1.v = *(const uint4*)(w1 + 32 + fq * 8);
      a0 = mfma16(x0.h, qa0.h, a0); a0 = mfma16(x1.h, qa1.h, a0);
      a1 = mfma16(y0.h, qa0.h, a1); a1 = mfma16(y1.h, qa1.h, a1);
      c0 = mfma16(x0.h, qb0.h, c0); c0 = mfma16(x1.h, qb1.h, c0);
      c1 = mfma16(y0.h, qb0.h, c1); c1 = mfma16(y1.h, qb1.h, c1);
      U4 o;
      o.w[0] = pack2(a0[0] * 0.125f, a0[1] * 0.125f); o.w[1] = pack2(a0[2] * 0.125f, a0[3] * 0.125f);
      o.w[2] = pack2(a1[0] * 0.125f, a1[1] * 0.125f); o.w[3] = pack2(a1[2] * 0.125f, a1[3] * 0.125f);
      qf0[s] = o.h;
      o.w[0] = pack2(c0[0] * 0.125f, c0[1] * 0.125f); o.w[1] = pack2(c0[2] * 0.125f, c0[3] * 0.125f);
      o.w[2] = pack2(c1[0] * 0.125f, c1[1] * 0.125f); o.w[3] = pack2(c1[2] * 0.125f, c1[3] * 0.125f);
      qf1[s] = o.h;
      __builtin_amdgcn_sched_barrier(0);
    }
  }
  const char* mbase = ws + O_MASK + ((size_t)b * T + q0) * 256;
  const unsigned mvo = (unsigned)fr * 256u;
  const u16* kg = (const u16*)(ws + O_CKVN) + (size_t)b * T * 256;
  const int nkt = (q0 + 32 + 63) >> 6;
#pragma unroll 1
  for (int pass = 0; pass < 2; ++pass) {
    const u16* vg = (const u16*)(ws + O_CKVNT) + ((size_t)b * 256 + pass * 128) * T;
    f32x4 ot0[8], ot1[8];
#pragma unroll
    for (int i = 0; i < 8; ++i) { ot0[i] = f32x4{0.f, 0.f, 0.f, 0.f}; ot1[i] = ot0[i]; }
    float m0 = -1e30f, l0 = 0.f, m1 = -1e30f, l1 = 0.f;
    u32x4 k0, k1, k2, k3, v0, v1;
    const unsigned kvo = (unsigned)(((tid >> 5) * 256 + (tid & 31) * 8) * 2);
    const unsigned vvo = (unsigned)(((tid >> 3) * T + (tid & 7) * 8) * 2);
    LAS unsigned char* ksl = (LAS unsigned char*)smem + ((tid >> 5) * LDK + (tid & 31) * 8) * 2;
    LAS unsigned char* vsl = (LAS unsigned char*)smem + 33792 + ((tid >> 3) * LDV + (tid & 7) * 8) * 2;
#define D_LOAD(ktt)                                                                                    \
  do {                                                                                                 \
    const char* kb_ = (const char*)kg + (size_t)(ktt) * (64 * 256 * 2);                                \
    const char* vb_ = (const char*)vg + (size_t)(ktt) * 128;                                           \
    unsigned kvo_ = kvo, vvo_ = vvo;                                                                   \
    asm volatile("" : "+v"(kvo_), "+v"(vvo_));                                                         \
    k0 = *(const u32x4*)(kb_ + kvo_); k1 = *(const u32x4*)(kb_ + 8192 + kvo_);                         \
    k2 = *(const u32x4*)(kb_ + 16384 + kvo_); k3 = *(const u32x4*)(kb_ + 24576 + kvo_);                \
    v0 = *(const u32x4*)(vb_ + vvo_); v1 = *(const u32x4*)(vb_ + (size_t)64 * T * 2 + vvo_);           \
  } while (0)
    D_LOAD(0);
#pragma unroll 1
    for (int kt = 0; kt < nkt; ++kt) {
      __syncthreads();
      *(LAS u32x4*)(ksl) = k0; *(LAS u32x4*)(ksl + 16 * LDK * 2) = k1; *(LAS u32x4*)(ksl + 32 * LDK * 2) = k2; *(LAS u32x4*)(ksl + 48 * LDK * 2) = k3;
      *(LAS u32x4*)(vsl) = v0; *(LAS u32x4*)(vsl + 64 * LDV * 2) = v1;
      __syncthreads();
      f32x4 st0[4], st1[4];
#pragma unroll
      for (int m = 0; m < 4; ++m) {
        st0[m] = f32x4{0.f, 0.f, 0.f, 0.f};
        st1[m] = st0[m];
        const u16* krow = Ks + (16 * m + fr) * LDK;
#pragma unroll
        for (int s = 0; s < 8; ++s) {
          const uint2 x = *(const uint2*)(krow + 32 * s + fq * 4), y = *(const uint2*)(krow + 32 * s + 16 + fq * 4);
          U4 a;
          a.w[0] = x.x; a.w[1] = x.y; a.w[2] = y.x; a.w[3] = y.y;
          st0[m] = mfma16(a.h, qf0[s], st0[m]);
          st1[m] = mfma16(a.h, qf1[s], st1[m]);
        }
        if (m == 1) __builtin_amdgcn_sched_barrier(0);
      }
      U4 pb0[2], pb1[2];
      float alpha0, alpha1;
#define D_SOFTMAX(ST, MROW, QPOS, MR, LR, ALPHA, PB)                                                   \
  do {                                                                                                 \
    const u32x2 mm = *(const u32x2*)(mbase + (MROW) + (size_t)kt * 8 + mvo);                           \
    float mx = (MR);                                                                                   \
    _Pragma("unroll") for (int m = 0; m < 4; ++m) _Pragma("unroll") for (int r = 0; r < 4; ++r) {      \
      const int dist = (QPOS) - (kt * 64 + 16 * m + fq * 4 + r);                                       \
      const float sv = ST[m][r] + bias[dist < 0 ? 0 : dist];                                           \
      ST[m][r] = sv;                                                                                   \
      if (((m < 2 ? mm.x : mm.y) >> ((m & 1) * 16 + fq * 4 + r)) & 1u) mx = fmaxf(mx, sv);             \
    }                                                                                                  \
    mx = fmaxf(mx, __shfl_xor(mx, 16));                                                                \
    mx = fmaxf(mx, __shfl_xor(mx, 32));                                                                \
    ALPHA = __expf((MR) - mx);                                                                         \
    float ls = 0.f;                                                                                    \
    _Pragma("unroll") for (int m = 0; m < 4; ++m) _Pragma("unroll") for (int r = 0; r < 4; ++r) {      \
      const bool okb = (((m < 2 ? mm.x : mm.y) >> ((m & 1) * 16 + fq * 4 + r)) & 1u) != 0;             \
      const float pv = okb ? __expf(ST[m][r] - mx) : 0.f;                                              \
      ST[m][r] = pv;                                                                                   \
      ls += pv;                                                                                        \
    }                                                                                                  \
    LR = LR * ALPHA + ls;                                                                              \
    MR = mx;                                                                                           \
    _Pragma("unroll") for (int s = 0; s < 2; ++s) {                                                    \
      PB[s].w[0] = pack2(ST[2 * s][0], ST[2 * s][1]);                                                  \
      PB[s].w[1] = pack2(ST[2 * s][2], ST[2 * s][3]);                                                  \
      PB[s].w[2] = pack2(ST[2 * s + 1][0], ST[2 * s + 1][1]);                                          \
      PB[s].w[3] = pack2(ST[2 * s + 1][2], ST[2 * s + 1][3]);                                          \
    }                                                                                                  \
  } while (0)
      D_SOFTMAX(st0, 0, qpos0, m0, l0, alpha0, pb0);
      D_SOFTMAX(st1, 4096, qpos1, m1, l1, alpha1, pb1);
      if (kt + 1 < nkt) D_LOAD(kt + 1);
#pragma unroll
      for (int i = 0; i < 8; ++i) { ot0[i] *= alpha0; ot1[i] *= alpha1; }
#pragma unroll
      for (int s = 0; s < 2; ++s) {
#pragma unroll
        for (int mt = 0; mt < 8; ++mt) {
          const u16* vrow = Vt + (16 * mt + fr) * LDV + 32 * s;
          const uint2 x = *(const uint2*)(vrow + fq * 4), y = *(const uint2*)(vrow + 16 + fq * 4);
          U4 a;
          a.w[0] = x.x; a.w[1] = x.y; a.w[2] = y.x; a.w[3] = y.y;
          ot0[mt] = mfma16(a.h, pb0[s].h, ot0[mt]);
          ot1[mt] = mfma16(a.h, pb1[s].h, ot1[mt]);
          if ((mt & 1) == 1) __builtin_amdgcn_sched_barrier(0);
        }
      }
    }
    l0 += __shfl_xor(l0, 16); l0 += __shfl_xor(l0, 32);
    l1 += __shfl_xor(l1, 16); l1 += __shfl_xor(l1, 32);
    const float inv0 = 1.f / l0, inv1 = 1.f / l1;
    u16* d0 = (u16*)(ws + O_OLAT) + tq0 * 2048 + h * 256 + pass * 128;
    u16* d1 = d0 + 16 * 2048;
#pragma unroll
    for (int mt = 0; mt < 8; ++mt) {
      *(uint2*)(d0 + 16 * mt + fq * 4) = make_uint2(pack2(ot0[mt][0] * inv0, ot0[mt][1] * inv0), pack2(ot0[mt][2] * inv0, ot0[mt][3] * inv0));
      *(uint2*)(d1 + 16 * mt + fq * 4) = make_uint2(pack2(ot1[mt][0] * inv1, ot1[mt][1] * inv1), pack2(ot1[mt][2] * inv1, ot1[mt][3] * inv1));
    }
  }
}

__device__ __forceinline__ int snake_slot(int round, int G) { return (round & 1) ? (round * G + (G - 1 - opaque_s((int)blockIdx.x))) : (round * G + opaque_s((int)blockIdx.x)); }

__device__ __forceinline__ void idx_item(const P& p, int b, int qb16, char* smem) {
  char* ws = opaque_p(p.ws);
  const int tid = opaque(threadIdx.x), lane = tid & 63, wid = tid >> 6, fr = lane & 15, fq = lane >> 4;
  constexpr int LDQ = 1032;
  u16* Qh = (u16*)smem;
  u16* Ql = (u16*)(smem + 16 * LDQ * 2);
  float* wiS = (float*)(smem + 2 * 16 * LDQ * 2);
  const int q0 = qb16 * 16;
  const size_t t0 = (size_t)b * T + q0;
  float* sbuf = (float*)(ws + O_SCR) + (size_t)opaque_s((int)blockIdx.x) * 16 * 2048;
  __syncthreads();
#pragma unroll
  for (int i = 0; i < 4; ++i) {
    const int ci = tid + NTH * i, row = ci >> 7, c8 = ci & 127;
    *(uint4*)(Qh + row * LDQ + c8 * 8) = *(const uint4*)((const u16*)(ws + O_QIHI) + (t0 + row) * 1024 + c8 * 8);
    if (!NOSPLIT) *(uint4*)(Ql + row * LDQ + c8 * 8) = *(const uint4*)((const u16*)(ws + O_QILO) + (t0 + row) * 1024 + c8 * 8);
  }
  if (tid < 256) {
    const int q = tid & 15, hh = tid >> 4;
    wiS[hh * 16 + q] = ((const float*)(ws + O_WIDX))[(t0 + q) * 16 + hh] * 0.25f;
  }
  __syncthreads();
  const int nslab = (q0 + 16 + 63) >> 6;
  const int qpos = q0 + fr;
  for (int slab = wid; slab < nslab; slab += 8) {
    const int kb = slab * 64;
    bf16x8 kh[4][2], kl[4][2];
#pragma unroll
    for (int m = 0; m < 4; ++m)
#pragma unroll
      for (int s = 0; s < 2; ++s) {
        const size_t off = ((size_t)b * T + kb + 16 * m + fr) * 64 + 32 * s + fq * 8;
        U4 a, c;
        a.v = *(const uint4*)((const u16*)(ws + O_KIHI) + off);
        c.v = *(const uint4*)((const u16*)(ws + O_KILO) + off);
        kh[m][s] = a.h;
        kl[m][s] = c.h;
      }
    f32x4 sc[4];
#pragma unroll
    for (int m = 0; m < 4; ++m) sc[m] = f32x4{0.f, 0.f, 0.f, 0.f};
#pragma unroll 4
    for (int h = 0; h < 16; ++h) {
      U4 bh0, bh1, bl0, bl1;
      bh0.v = *(const uint4*)(Qh + fr * LDQ + h * 64 + fq * 8);
      bh1.v = *(const uint4*)(Qh + fr * LDQ + h * 64 + 32 + fq * 8);
      bl0.v = *(const uint4*)(Ql + fr * LDQ + h * 64 + fq * 8);
      bl1.v = *(const uint4*)(Ql + fr * LDQ + h * 64 + 32 + fq * 8);
      const float w = wiS[h * 16 + fr];
#pragma unroll
      for (int m = 0; m < 4; ++m) {
        f32x4 a = {0.f, 0.f, 0.f, 0.f};
        if (NOSPLIT == 0) {
          a = mfma16(kl[m][0], bh0.h, a);
          a = mfma16(kl[m][1], bh1.h, a);
          a = mfma16(kh[m][0], bl0.h, a);
          a = mfma16(kh[m][1], bl1.h, a);
        }
        a = mfma16(kh[m][0], bh0.h, a);
        a = mfma16(kh[m][1], bh1.h, a);
#pragma unroll
        for (int r = 0; r < 4; ++r) sc[m][r] += w * fmaxf(a[r], 0.f);
      }
    }
#pragma unroll
    for (int m = 0; m < 4; ++m) {
      const int key = kb + 16 * m + fq * 4;
      float4 o;
      o.x = (key + 0 <= qpos) ? sc[m][0] : -INFINITY;
      o.y = (key + 1 <= qpos) ? sc[m][1] : -INFINITY;
      o.z = (key + 2 <= qpos) ? sc[m][2] : -INFINITY;
      o.w = (key + 3 <= qpos) ? sc[m][3] : -INFINITY;
      *(float4*)(sbuf + fr * 2048 + key) = o;
    }
  }
  __syncthreads();
  {
    const int lane_q = opaque(lane);
    int ns_q = nslab;
    asm volatile("" : "+s"(ns_q));
    uint32_t uA[32], uB[32];
#define SEL_LOAD(U, QI)                                                                      \
  _Pragma("unroll") for (int j = 0; j < 32; ++j) {                                           \
    if (j < ns_q) {                                                                          \
      const uint32_t bits = __float_as_uint(sbuf[(QI) * 2048 + j * 64 + lane_q]);            \
      U[j] = (bits & 0x80000000u) ? ~bits : (bits | 0x80000000u);                            \
    } else U[j] = 0u;                                                                        \
  }
#define SEL_RUN(U, QI)                                                                       \
  do {                                                                                       \
    const int qp = q0 + (QI);                                                                \
    uint32_t* mdst = (uint32_t*)(ws + O_MASK) + (t0 + (QI)) * 64;                            \
    if (qp + 1 <= 256) {                                                                     \
      const int lo = 32 * lane_q;                                                            \
      uint32_t v;                                                                            \
      if (qp >= lo + 31) v = 0xffffffffu;                                                    \
      else if (qp < lo) v = 0u;                                                              \
      else v = (2u << (qp - lo)) - 1u;                                                       \
      mdst[lane_q] = v;                                                                      \
    } else {                                                                                 \
      uint32_t thr = 0;                                                                      \
      for (int bit = 31; bit >= 0; --bit) {                                                  \
        const uint32_t cand = thr | (1u << bit);                                             \
        int cnt = 0;                                                                         \
        _Pragma("unroll") for (int j = 0; j < 32; ++j) {                                     \
          cnt += __popcll(__ballot(U[j] >= cand));                                           \
          if ((j & 3) == 3) __builtin_amdgcn_sched_barrier(0);                               \
        }                                                                                    \
        if (cnt >= 256) thr = cand;                                                          \
        if (cnt == 256) break;                           \
      }                                                                                      \
      uint32_t mylo = 0, myhi = 0;                                                           \
      _Pragma("unroll") for (int j = 0; j < 32; ++j) {                                       \
        const unsigned long long bm = __ballot(U[j] >= thr);                                 \
        if (lane_q == j) { mylo = (uint32_t)bm; myhi = (uint32_t)(bm >> 32); }               \
        if ((j & 3) == 3) __builtin_amdgcn_sched_barrier(0);                                 \
      }                                                                                      \
      if (lane_q < 32) *(uint2*)(mdst + 2 * lane_q) = make_uint2(mylo, myhi);                \
    }                                                                                        \
  } while (0)
    SEL_LOAD(uA, wid)
    SEL_LOAD(uB, wid + 8)
    SEL_RUN(uA, wid);
    SEL_RUN(uB, wid + 8);
  }
}

__device__ __forceinline__ void phase_p4(const P& p, int l, char* smem) {
  char* ws = opaque_p(p.ws);
  const int G = gridDim.x;
  for (int round = 0;; ++round) {
    const int s = snake_slot(round, G);
    if (round * G >= 2048) break;
    if (s < 2048) idx_item(p, s & 15, 127 - (s >> 4), smem);
  }
  if (G == 256) {
    const int w = opaque_s((int)blockIdx.x), x = w & 7, j = w >> 3, psel = j >> 4, qbi = j & 15;
    for (int r = 0; r < 8; ++r) {
      const int pg = x * 16 + 2 * r + psel;
      attn_item<false>(p, pg >> 3, (r & 1) ? qbi : 15 - qbi, pg & 7, smem);
    }
  } else {
    for (int round = 0;; ++round) {
      const int s = snake_slot(round, G);
      if (round * G >= 2048) break;
      if (s < 2048) attn_item<false>(p, (s >> 3) & 15, 15 - (s >> 7), s & 7, smem);
    }
  }
  const float* d_skip = p.in(16) + l * 512;
  for (int it = opaque_s((int)blockIdx.x); it < 32 * 8 * 4; it += gridDim.x) {
    const int tn = it & 3, tm = (it >> 2) & 7, g = it >> 5;
    f32x4 acc[2][4];
    zero_acc(acc);
    {
      S5UAddr fa{(const u16*)(ws + O_U) + g * 16, tm * 128};
      S5ToepAddr fb{(const u16*)(ws + O_KTAB) + (size_t)g * 32 * 256, tn * 128};
      TileLd<S5UAddr> la(fa);
      TileLd<S5ToepAddr> lb(fb);
      gemm_loop(acc, la, lb, 8, smem);
    }
    {
      RowMajor fa{(const u16*)(ws + O_SPREV) + ((size_t)g * 1024 + tm * 128) * 128, 128};
      RowMajor fb{(const u16*)(ws + O_CM) + ((size_t)g * 512 + tn * 128) * 128, 128};
      TileLd<RowMajor> la(fa);
      TileLd<RowMajor> lb(fb);
      gemm_loop(acc, la, lb, 2, smem);
    }
    epi_each(acc, [&](int lr, int lc, f32x4 v) {
      const int col = tn * 128 + lc, i = col >> 4, po = col & 15, ch = g * 16 + po;
      const float dk = d_skip[ch];
#pragma unroll
      for (int r = 0; r < 4; ++r) {
        const int rc = tm * 128 + lr + r;
        const size_t t = (size_t)rc * 32 + i;
        const float uu = bf2f(((const u16*)(ws + O_U))[t * 512 + ch]);
        ((u16*)(ws + O_YACT))[t * 512 + ch] = f2bf(gelu_tanh(v[r] + dk * uu));
      }
    });
  }
}

__device__ __forceinline__ void phase_p5(const P& p, int l, char* smem) {
  char* ws = opaque_p(p.ws);
  const int G = gridDim.x;
  __syncthreads();
  {
    float* bias = (float*)(smem + 52224);
    const float* bsrc = (const float*)(ws + O_BIASD);
    for (int i = opaque(threadIdx.x); i < 8 * 2048; i += NTH) bias[i] = bsrc[i];
  }
  if (G == 256) {
    const int w = opaque_s((int)blockIdx.x), x = w & 7, j = w >> 3;
    for (int r = 0; r < 4; ++r) dsa_item(p, 2 * x + (r >> 1), (r & 1) ? j : 63 - j, smem);
  } else {
    for (int round = 0;; ++round) {
      const int s = snake_slot(round, G);
      if (round * G >= 1024) break;
      if (s < 1024) dsa_item(p, s & 15, 63 - (s >> 4), smem);
    }
  }
  const float* b_glu = p.in(18) + l * 512;
  for (int it = opaque_s((int)blockIdx.x); it < 128 * 2; it += gridDim.x) {
    const int tn = it & 1, tm = it >> 1;
    Acc256 acc;
    zero256(acc);
    gemm256(acc, (const u16*)(ws + O_YACT) + (size_t)tm * 256 * 512, 512, (const u16*)(ws + O_WGLU) + (size_t)tn * 256 * 512, 512, 512, smem);
    epi256(acc, [&](int lr, int lc, f32x4 v) {
      const int col = tn * 256 + lc;
      const float bg = b_glu[col];
#pragma unroll
      for (int r = 0; r < 4; ++r) {
        const size_t t = (size_t)tm * 256 + lr + r;
        const float y = bf2f(((const u16*)(ws + O_YACT))[t * 512 + col]);
        ((u16*)(ws + O_OB))[t * 512 + col] = f2bf(y * sigmoidf_(v[r] + bg));
      }
    });
  }
}


__device__ __forceinline__ void phase_oa(const P& p, char* smem) {
  char* ws = opaque_p(p.ws);
  for (int it = xcd_first_tile(); it < 128 * 2; it += gridDim.x) {
    const int tn = it & 1, tm = it >> 1;
    Acc256 acc;
    zero256(acc);
    gemm256(acc, (const u16*)(ws + O_OLAT) + (size_t)tm * 256 * 2048 + tn * 1024, 2048, (const u16*)(ws + O_WUVBD) + (size_t)tn * 256 * 2048 + tn * 1024, 2048, 1024, smem);
    epi256(acc, [&](int lr, int lc, f32x4 v) {
#pragma unroll
      for (int r = 0; r < 4; ++r) ((u16*)(ws + O_OA))[(size_t)(tm * 256 + lr + r) * 512 + tn * 256 + lc] = f2bf(v[r]);
    });
  }
}

__device__ __forceinline__ void phase_merge(const P& p, char* smem) {
  char* ws = opaque_p(p.ws);
  for (int it = xcd_first_tile(); it < 128 * 8; it += gridDim.x) {
    const int tn = it & 7, tm = it >> 3;
#define MRG_PTRS                                                                                                   \
  const int tid_ = opaque(threadIdx.x);                                                                            \
  uint4* gst = (uint4*)(opaque_p(p.ws) + O_GATE) + (size_t)opaque_s((int)blockIdx.x) * 16 * NTH + tid_;            \
  float4* mst = (float4*)(opaque_p(p.ws) + O_MRG) + (size_t)opaque_s((int)blockIdx.x) * 32 * NTH + tid_;
#pragma unroll 1
    for (int n = 0; n < 3; ++n) {
      {
        Acc256 acc;
        zero256(acc);
        gemm256(acc, (const u16*)(ws + O_XH) + (size_t)tm * 256 * DM, DM, (const u16*)(ws + O_WG) + ((size_t)n * DM + tn * 256) * DM, DM, DM, smem);
        MRG_PTRS
        (void)mst;
#pragma unroll
        for (int a = 0; a < 2; ++a)
#pragma unroll
          for (int b = 0; b < 2; ++b)
#pragma unroll
            for (int m = 0; m < 4; ++m) {
              const f32x4 v0 = acc[a][b][m][0], v1 = acc[a][b][m][1];
              *gst = make_uint4(pack2(sigmoidf_(v0[0]), sigmoidf_(v0[1])), pack2(sigmoidf_(v0[2]), sigmoidf_(v0[3])),
                                pack2(sigmoidf_(v1[0]), sigmoidf_(v1[1])), pack2(sigmoidf_(v1[2]), sigmoidf_(v1[3])));
              gst += NTH;
            }
      }
      {
        Acc256 acc;
        zero256(acc);
        const size_t ooff = (n == 0 ? O_OA : (n == 1 ? O_OB : O_OC));
        gemm256(acc, (const u16*)(ws + ooff) + (size_t)tm * 256 * 512, 512, (const u16*)(ws + O_WBR) + ((size_t)n * DM + tn * 256) * 512, 512, 512, smem);
        const float keep = (n > 0) ? 1.f : 0.f;
        MRG_PTRS
#pragma unroll
        for (int a = 0; a < 2; ++a)
#pragma unroll
          for (int b = 0; b < 2; ++b)
#pragma unroll
            for (int m = 0; m < 4; ++m) {
              const uint4 gg = *gst;
              gst += NTH;
#pragma unroll
              for (int c = 0; c < 2; ++c) {
                const f32x4 v = acc[a][b][m][c];
                const uint32_t g0 = c ? gg.z : gg.x, g1 = c ? gg.w : gg.y;
                float4 pm = make_float4(0.f, 0.f, 0.f, 0.f);
                if (n > 0) pm = *mst;
                pm.x = pm.x * keep + bf2f((u16)(g0 & 0xffff)) * v[0];
                pm.y = pm.y * keep + bf2f((u16)(g0 >> 16)) * v[1];
                pm.z = pm.z * keep + bf2f((u16)(g1 & 0xffff)) * v[2];
                pm.w = pm.w * keep + bf2f((u16)(g1 >> 16)) * v[3];
                *mst = pm;
                mst += NTH;
              }
              __builtin_amdgcn_sched_barrier(0);
            }
      }
    }
    {
      MRG_PTRS
      (void)gst;
      const int lane = tid_ & 63, wid = tid_ >> 6, wr = wid >> 2, wc = wid & 3, fr = lane & 15, fq = lane >> 4;
      u16* dbase = (u16*)(ws + O_MERGED) + (size_t)(tm * 256 + wr * 64 + fq * 4) * DM + tn * 256 + wc * 32 + fr;
#pragma unroll
      for (int a = 0; a < 2; ++a)
#pragma unroll
        for (int b = 0; b < 2; ++b)
#pragma unroll
          for (int m = 0; m < 4; ++m) {
#pragma unroll
            for (int c = 0; c < 2; ++c) {
              const float4 pm = *mst;
              mst += NTH;
              u16* d = dbase + (size_t)(a * 128 + m * 16) * DM + b * 128 + c * 16;
              d[0] = f2bf(pm.x); d[DM] = f2bf(pm.y); d[2 * DM] = f2bf(pm.z); d[3 * DM] = f2bf(pm.w);
            }
            __builtin_amdgcn_sched_barrier(0);
          }
    }
  }
}

__device__ __forceinline__ void phase_wout(const P& p, const float* x, char* smem) {
  char* ws = opaque_p(p.ws);
  float* z = (float*)(ws + O_X1);
  for (int it = xcd_first_tile(); it < 128 * 8; it += gridDim.x) {
    const int tn = it & 7, tm = it >> 3;
    Acc256 acc;
    zero256(acc);
    gemm256(acc, (const u16*)(ws + O_MERGED) + (size_t)tm * 256 * DM, DM, (const u16*)(ws + O_WOUT) + (size_t)tn * 256 * DM, DM, DM, smem);
    epi256(acc, [&](int lr, int lc, f32x4 v) {
#pragma unroll
      for (int r = 0; r < 4; ++r) {
        const size_t o = (size_t)(tm * 256 + lr + r) * DM + tn * 256 + lc;
        z[o] = ALPHA * x[o] + v[r];
      }
    });
  }
}

__device__ __forceinline__ void phase_ln(float* z, const float* g, const float* bta, u16* ohi, u16* olo) {
  const int lane = opaque(threadIdx.x) & 63, wid = opaque(threadIdx.x) >> 6;
  (void)olo;
  for (int it = opaque_s((int)blockIdx.x); it < NTOK / 16; it += gridDim.x) {
    const size_t r0 = (size_t)it * 16 + wid * 2;
    float4* rowa = (float4*)(z + r0 * DM);
    float4* rowb = (float4*)(z + (r0 + 1) * DM);
    float4 va[8], vb[8];
    float sa = 0.f, sb = 0.f;
#pragma unroll
    for (int i = 0; i < 8; ++i) { va[i] = rowa[lane + 64 * i]; vb[i] = rowb[lane + 64 * i]; }
#pragma unroll
    for (int i = 0; i < 8; ++i) { sa += va[i].x + va[i].y + va[i].z + va[i].w; sb += vb[i].x + vb[i].y + vb[i].z + vb[i].w; }
    sa = wave_sum(sa);
    sb = wave_sum(sb);
    const float mua = sa * (1.f / DM), mub = sb * (1.f / DM);
    float qa = 0.f, qb = 0.f;
#pragma unroll
    for (int i = 0; i < 8; ++i) {
      va[i].x -= mua; va[i].y -= mua; va[i].z -= mua; va[i].w -= mua;
      vb[i].x -= mub; vb[i].y -= mub; vb[i].z -= mub; vb[i].w -= mub;
      qa += va[i].x * va[i].x + va[i].y * va[i].y + va[i].z * va[i].z + va[i].w * va[i].w;
      qb += vb[i].x * vb[i].x + vb[i].y * vb[i].y + vb[i].z * vb[i].z + vb[i].w * vb[i].w;
    }
    qa = wave_sum(qa);
    qb = wave_sum(qb);
    const float rsa = rsqrtf(qa * (1.f / DM) + 1e-5f), rsb = rsqrtf(qb * (1.f / DM) + 1e-5f);
#pragma unroll
    for (int i = 0; i < 8; ++i) {
      const float4 gg = ((const float4*)g)[lane + 64 * i], bb = ((const float4*)bta)[lane + 64 * i];
      float4 oa, ob;
      oa.x = va[i].x * rsa * gg.x + bb.x; oa.y = va[i].y * rsa * gg.y + bb.y;
      oa.z = va[i].z * rsa * gg.z + bb.z; oa.w = va[i].w * rsa * gg.w + bb.w;
      ob.x = vb[i].x * rsb * gg.x + bb.x; ob.y = vb[i].y * rsb * gg.y + bb.y;
      ob.z = vb[i].z * rsb * gg.z + bb.z; ob.w = vb[i].w * rsb * gg.w + bb.w;
      rowa[lane + 64 * i] = oa;
      rowb[lane + 64 * i] = ob;
      if (ohi) {
        ((uint2*)(ohi + r0 * DM))[lane + 64 * i] = make_uint2(pack2(oa.x, oa.y), pack2(oa.z, oa.w));
        ((uint2*)(ohi + (r0 + 1) * DM))[lane + 64 * i] = make_uint2(pack2(ob.x, ob.y), pack2(ob.z, ob.w));
      }
    }
  }
}

__device__ __forceinline__ void phase_up(const P& p, int l, char* smem) {
  char* ws = opaque_p(p.ws);
  const float* cw = p.in(24) + (size_t)l * 3 * 2 * DFF;
  const float* cb = p.in(25) + (size_t)l * 2 * DFF;
  u16* hA = (u16*)smem;
  u16* hV = (u16*)(smem + 65536);
  const int tid = opaque(threadIdx.x);
  for (int it = xcd_first_tile(); it < 33 * 176; it += gridDim.x) {
    const int mb = it / 176, rem = it - mb * 176, tn = rem >> 2, mt = mb * 4 + (rem & 3);
    if (mt >= 130) continue;
    const long tfirst = (long)mt * 254 - 2;
    Acc256 acc;
    zero256(acc);
    gemm256(acc, (const u16*)(ws + O_X1B) + tfirst * DM, DM, (const u16*)(ws + O_WUP) + (size_t)tn * 256 * DM, DM, DM, smem);
    __syncthreads();
    {
      const int lane = tid & 63, wid = tid >> 6, wr = wid >> 2, wc = wid & 3, fr = lane & 15, fq = lane >> 4;
      LAS u16* bA = (LAS u16*)(LAS unsigned char*)smem + opaque((wr * 64 + fq * 4) * 128 + wc * 32 + fr);
#pragma unroll
      for (int a = 0; a < 2; ++a)
#pragma unroll
        for (int m = 0; m < 4; ++m) {
#pragma unroll
          for (int c = 0; c < 2; ++c) {
#pragma unroll
            for (int r = 0; r < 4; ++r) {
              bA[(a * 128 + m * 16 + r) * 128 + c * 16] = f2bf(acc[a][0][m][c][r]);
              bA[32768 + (a * 128 + m * 16 + r) * 128 + c * 16] = f2bf(acc[a][1][m][c][r]);
            }
          }
          __builtin_amdgcn_sched_barrier(0);
        }
    }
    __syncthreads();
    {
      typedef __attribute__((ext_vector_type(2))) float f2;
      const int c = (tid & 63) * 2, rg = tid >> 6;
      const int ca = tn * 128 + c, cv = DFF + ca;
      const f2 wa0 = *(const f2*)(cw + ca), wa1 = *(const f2*)(cw + 2 * DFF + ca), wa2 = *(const f2*)(cw + 4 * DFF + ca), ba = *(const f2*)(cb + ca);
      const f2 wv0 = *(const f2*)(cw + cv), wv1 = *(const f2*)(cw + 2 * DFF + cv), wv2 = *(const f2*)(cw + 4 * DFF + cv), bv = *(const f2*)(cb + cv);
      const int i0 = (rg == 0) ? 2 : rg * 32, i1 = rg * 32 + 32;
      auto ld2 = [&](const u16* base, int row) -> f2 {
        const uint32_t w = *(const uint32_t*)(base + row * 128 + c);
        f2 r;
        r.x = __uint_as_float(w << 16);
        r.y = __uint_as_float(w & 0xffff0000u);
        return r;
      };
      f2 a2 = ld2(hA, i0 - 2), a1 = ld2(hA, i0 - 1), v2 = ld2(hV, i0 - 2), v1 = ld2(hV, i0 - 1);
      u16* dst = (u16*)(ws + O_ACT) + ca;
      for (int i = i0; i < i1; ++i) {
        const f2 a0 = ld2(hA, i), v0 = ld2(hV, i);
        const long t = tfirst + i;
        if (t < NTOK) {
          const int tt = (int)(t & 2047);
          const float k2 = (tt >= 2) ? 1.f : 0.f, k1 = (tt >= 1) ? 1.f : 0.f;
          const f2 ha = ba + (wa0 * a2) * k2 + (wa1 * a1) * k1 + wa2 * a0;
          const f2 hv = bv + (wv0 * v2) * k2 + (wv1 * v1) * k1 + wv2 * v0;
          const f2 u = (ha + ha * ha * ha * 0.044715f) * (2.f * 0.7978845608028654f);
          f2 gl;
          gl.x = ha.x / (1.f + __expf(-u.x));
          gl.y = ha.y / (1.f + __expf(-u.y));
          const f2 o = gl * hv;
          *(uint32_t*)(dst + (size_t)t * DFF) = pack2(o.x, o.y);
        }
        a2 = a1; a1 = a0; v2 = v1; v1 = v0;
      }
    }
  }
}

__device__ __forceinline__ void phase_down(const P& p, char* smem) {
  char* ws = opaque_p(p.ws);
  const float* x1 = (const float*)(ws + O_X1);
  float* z = p.out;
  for (int it = xcd_first_tile(); it < 128 * 8; it += gridDim.x) {
    const int tn = it & 7, tm = it >> 3;
    Acc256 acc;
    zero256(acc);
    gemm256(acc, (const u16*)(ws + O_ACT) + (size_t)tm * 256 * DFF, DFF, (const u16*)(ws + O_WDOWN) + (size_t)tn * 256 * DFF, DFF, DFF, smem);
    epi256(acc, [&](int lr, int lc, f32x4 v) {
#pragma unroll
      for (int r = 0; r < 4; ++r) {
        const size_t o = (size_t)(tm * 256 + lr + r) * DM + tn * 256 + lc;
        z[o] = ALPHA * x1[o] + v[r];
      }
    });
  }
}


constexpr size_t O_BAR = 1020 * MiB;
#define XB_TMO 128
#define XB_XCNT(j) (256 + 64 * (j))
#define XB_XSUB(j) (1280 + 64 * (j))
#define XB_XGEN(j) (2304 + 64 * (j))
#define XB_TOP 3328
#define XB_TOPGEN 3392
#define XCD_BAR_WORDS 3456
#define XB_SPIN_CAP (1u << 22)
__device__ __forceinline__ unsigned xb_ld(unsigned* p) { return __hip_atomic_load(p, __ATOMIC_RELAXED, __HIP_MEMORY_SCOPE_AGENT); }
__device__ __forceinline__ unsigned xb_add(unsigned* p, unsigned v) { return __hip_atomic_fetch_add(p, v, __ATOMIC_RELAXED, __HIP_MEMORY_SCOPE_AGENT); }
__device__ __forceinline__ unsigned xb_xcc_id() { return (unsigned)__builtin_amdgcn_s_getreg((3 << 11) | 20) & 0xFu; }
#define XB_SPIN(cond, bar)                                                               \
  do {                                                                                   \
    unsigned _sp = 0;                                                                    \
    while (cond) {                                                                       \
      __builtin_amdgcn_s_sleep(1);                                                       \
      if ((++_sp & 255u) == 0u) {                                                        \
        if (xb_ld(&(bar)[XB_TMO])) break;                                                \
        if (_sp > XB_SPIN_CAP) { atomicAdd(&(bar)[XB_TMO], 1u); break; }                 \
      }                                                                                  \
    }                                                                                    \
  } while (0)
__device__ __forceinline__ void xcd_barrier_complete(unsigned* bar, unsigned x, unsigned& nloc, unsigned& nx) {
  const unsigned G = gridDim.x;
  unsigned sum, cnt, mine, sp = 0u;
  for (;;) {
    sum = 0u; cnt = 0u; mine = 0u;
#pragma unroll
    for (unsigned j = 0; j < 16; ++j) {
      const unsigned c = xb_ld(&bar[XB_XCNT(j)]);
      sum += c;
      cnt += (c > 0u) ? 1u : 0u;
      mine = (j == x) ? c : mine;
    }
    if (sum == G) break;
    __builtin_amdgcn_s_sleep(1);
    if ((++sp & 255u) == 0u) {
      if (xb_ld(&bar[XB_TMO])) break;
      if (sp > XB_SPIN_CAP) { atomicAdd(&bar[XB_TMO], 1u); break; }
    }
  }
  nloc = mine > 0u ? mine : 1u;
  nx = cnt > 0u ? cnt : 1u;
}
__device__ __forceinline__ void xcd_barrier(char* ws_, volatile LAS unsigned* st) {
  asm volatile("s_waitcnt vmcnt(0)" ::: "memory");
  __syncthreads();
  if (threadIdx.x == 0) {
    unsigned* bar = (unsigned*)(opaque_p(ws_) + O_BAR);
    const unsigned x = xb_xcc_id();
    __builtin_amdgcn_s_waitcnt(0);
    unsigned nloc = st[0], nx = st[1];
    if (nloc == 0u) {
      xcd_barrier_complete(bar, x, nloc, nx);
      st[0] = nloc;
      st[1] = nx;
    }
    const unsigned old = xb_add(&bar[XB_XSUB(x)], 1u);
    const unsigned gen = old / nloc;
    if (old + 1u == (gen + 1u) * nloc) {
      __builtin_amdgcn_fence(__ATOMIC_RELEASE, "agent");
      asm volatile("s_waitcnt vmcnt(0)" ::: "memory");
      const unsigned og = xb_add(&bar[XB_TOP], 1u);
      const unsigned tg = og / nx;
      if (og + 1u == (tg + 1u) * nx) xb_add(&bar[XB_TOPGEN], 1u);
      else XB_SPIN(xb_ld(&bar[XB_TOPGEN]) == tg, bar);
      __builtin_amdgcn_fence(__ATOMIC_ACQUIRE, "agent");
      xb_add(&bar[XB_XGEN(x)], 1u);
      asm volatile("s_waitcnt vmcnt(0)" ::: "memory");
    } else {
      XB_SPIN(xb_ld(&bar[XB_XGEN(x)]) == gen, bar);
      __builtin_amdgcn_fence(__ATOMIC_ACQUIRE, "agent");
      asm volatile("s_waitcnt vmcnt(0)" ::: "memory");
    }
  }
  __syncthreads();
}

__global__ void __launch_bounds__(512, 2) mega(PK pk) {
  extern __shared__ __attribute__((aligned(16))) char smem[];
  cg::grid_group grid = cg::this_grid();
  {
    LAS unsigned long long* tabw = (LAS unsigned long long*)(LAS unsigned char*)(smem + 131072);
    if (opaque(threadIdx.x) == 0) {
#pragma unroll
      for (int i = 0; i < 29; ++i) tabw[i] = (unsigned long long)pk.in[i];
    }
    volatile LAS unsigned* stw = (volatile LAS unsigned*)(LAS unsigned char*)(smem + 131072 + 240);
    if (threadIdx.x == 0) { stw[0] = 0u; stw[1] = 0u; }
    __syncthreads();
    if (threadIdx.x == 0) (void)xb_add((unsigned*)(pk.ws + O_BAR) + XB_XCNT(xb_xcc_id()), 1u);
  }
  volatile LAS unsigned* xst = (volatile LAS unsigned*)(LAS unsigned char*)(smem + 131072 + 240);
  P p;
  p.tab = (const LAS unsigned long long*)(LAS unsigned char*)(smem + 131072);
  p.out = pk.out;
  p.ws = pk.ws;
#pragma unroll
  for (int l = 0; l < 2; ++l) {
    const float* x = (l == 0) ? p.in(0) : p.out;
    phase_prep(p, l, smem);
    if (l == 0) grid.sync(); else xcd_barrier(p.ws, xst);
    phase_gemm_in(p, smem);
    xcd_barrier(p.ws, xst);
    phase_p2(p, l, smem);
    xcd_barrier(p.ws, xst);
    phase_p3(p, smem);
    xcd_barrier(p.ws, xst);
    phase_p4(p, l, smem);
    xcd_barrier(p.ws, xst);
    phase_p5(p, l, smem);
    xcd_barrier(p.ws, xst);
    phase_oa(p, smem);
    xcd_barrier(p.ws, xst);
    phase_merge(p, smem);
    xcd_barrier(p.ws, xst);
    phase_wout(p, x, smem);
    xcd_barrier(p.ws, xst);
    phase_ln((float*)(p.ws + O_X1), p.in(21) + l * DM, p.in(22) + l * DM, (u16*)(p.ws + O_X1B), nullptr);
    xcd_barrier(p.ws, xst);
    phase_up(p, l, smem);
    xcd_barrier(p.ws, xst);
    phase_down(p, smem);
    xcd_barrier(p.ws, xst);
    phase_ln(p.out, p.in(27) + l * DM, p.in(28) + l * DM, l == 0 ? (u16*)(p.ws + O_XH) : nullptr, (l == 0 && !NOSPLIT) ? (u16*)(p.ws + O_XL) : nullptr);
  }
}

extern "C" void kernel_launch(void* const* d_in, const int* in_sizes, int n_in, void* d_out, int out_size, void* d_ws, size_t ws_size,
                              hipStream_t stream) {
  static int grid_blocks = 0;
  if (!grid_blocks) {
    int dev = 0, cus = 0;
    (void)hipGetDevice(&dev);
    (void)hipDeviceGetAttribute(&cus, hipDeviceAttributeMultiprocessorCount, dev);
    (void)hipFuncSetAttribute((const void*)mega, hipFuncAttributeMaxDynamicSharedMemorySize, SMEM_BYTES);
    grid_blocks = cus;
    if (ws_size < 1020 * MiB) fprintf(stderr, "kernel_launch: workspace too small: %zu\n", ws_size);
  }
  PK p{};
  for (int i = 0; i < 29; ++i) p.in[i] = (const float*)d_in[i];
  p.out = (float*)d_out;
  p.ws = (char*)d_ws;
  (void)hipMemsetAsync((char*)d_ws + O_BAR, 0, XCD_BAR_WORDS * 4, stream);
  void* args[] = {&p};
  hipError_t e = hipLaunchCooperativeKernel((const void*)mega, dim3(grid_blocks), dim3(NTH), args, SMEM_BYTES, stream);
  if (e != hipSuccess) fprintf(stderr, "cooperative launch failed: %s (grid %d)\n", hipGetErrorString(e), grid_blocks);
}
```
